# Optimizing an MI355X kernel written in HIP

```python
import functools
import jax, jax.numpy as jnp
from jax import lax
import numpy as np

D_MODEL = 2048
BATCH = 8
SEQ = 2048
DEPTH = 2

MIX_WIDTH = D_MODEL
HEAD_DIM = 128
Q_BLOCK = 128
SB_WIDTH = MIX_WIDTH // 2
SB_HEADS = SB_WIDTH // HEAD_DIM
SC_WIDTH = MIX_WIDTH - SB_WIDTH
SC_GROUPS = SC_WIDTH // HEAD_DIM
CONV_WIDTH = 3
CHUNK = 128
SG_WIDTH = MIX_WIDTH // 2
SG_GROUP_DIM = 128
SG_GROUPS = SG_WIDTH // SG_GROUP_DIM
FOX_WIDTH = MIX_WIDTH - SG_WIDTH
FOX_HEADS = FOX_WIDTH // HEAD_DIM
IN_AB = 3 * SB_WIDTH + 3 * SC_WIDTH
IN_CD = 2 * SG_WIDTH + 3 * FOX_WIDTH + FOX_HEADS
D_FF = 5632
EPS = 1e-6

kernel_name = "hybrid_stickbreak_shortconv_chunkgmlp_fox_block"


def rmsnorm(x, g):
    xf = x.astype(jnp.float32)
    y = xf * lax.rsqrt(jnp.mean(xf * xf, axis=-1, keepdims=True) + EPS)
    return (y * g.astype(jnp.float32)).astype(x.dtype)


def layernorm(x, g):
    xf = x.astype(jnp.float32)
    mu = jnp.mean(xf, axis=-1, keepdims=True)
    xc = xf - mu
    y = xc * lax.rsqrt(jnp.mean(xc * xc, axis=-1, keepdims=True) + EPS)
    return (y * g.astype(jnp.float32)).astype(x.dtype)


def causal_dwconv(x, w):
    K = w.shape[0]
    S = x.shape[1]
    xp = jnp.pad(x, ((0, 0), (K - 1, 0), (0, 0)))
    y = xp[:, 0:S] * w[0]
    for j in range(1, K):
        y = y + xp[:, j:j + S] * w[j]
    return y


def split_heads(t, n_heads):
    return t.reshape(t.shape[0], t.shape[1], n_heads, -1)


def stick_breaking_attention(q, k, v):
    S = q.shape[1]
    scale = HEAD_DIM ** -0.5
    outs = []
    for i in range(S // Q_BLOCK):
        q0 = i * Q_BLOCK
        kend = q0 + Q_BLOCK
        qb = q[:, q0:kend].astype(jnp.float32)
        kb = k[:, :kend].astype(jnp.float32)
        vb = v[:, :kend].astype(jnp.float32)
        z = jnp.einsum('bqhd,bkhd->bhqk', qb, kb) * scale
        t_idx = q0 + jnp.arange(Q_BLOCK)[:, None]
        s_idx = jnp.arange(kend)[None, :]
        mask = s_idx < t_idx
        log_1mb = jnp.where(mask, jax.nn.log_sigmoid(-z), 0.0)
        later = lax.cumsum(log_1mb, axis=3, reverse=True) - log_1mb
        a = jnp.where(mask, jnp.exp(jax.nn.log_sigmoid(z) + later), 0.0)
        outs.append(jnp.einsum('bhqk,bkhd->bqhd', a, vb))
    return jnp.concatenate(outs, axis=1).astype(q.dtype)


def forgetting_attention(q, k, v, log_f):
    S = q.shape[1]
    scale = HEAD_DIM ** -0.5
    c = jnp.cumsum(log_f, axis=1).transpose(0, 2, 1)
    outs = []
    for i in range(S // Q_BLOCK):
        q0 = i * Q_BLOCK
        kend = q0 + Q_BLOCK
        qb = q[:, q0:kend].astype(jnp.float32)
        kb = k[:, :kend].astype(jnp.float32)
        vb = v[:, :kend].astype(jnp.float32)
        logits = jnp.einsum('bqhd,bkhd->bhqk', qb, kb) * scale
        logits = logits + c[:, :, q0:kend, None] - c[:, :, None, :kend]
        t_idx = q0 + jnp.arange(Q_BLOCK)[:, None]
        s_idx = jnp.arange(kend)[None, :]
        p = jax.nn.softmax(jnp.where(s_idx <= t_idx, logits, -jnp.inf), axis=-1)
        outs.append(jnp.einsum('bhqk,bkhd->bqhd', p, vb))
    return jnp.concatenate(outs, axis=1).astype(q.dtype)


def chunked_spatial_gate(u, v, w_s, b_s, g):
    B, S, W = v.shape
    v = layernorm(v, g)
    vc = v.reshape(B, S // CHUNK, CHUNK, SG_GROUPS, SG_GROUP_DIM)
    w = w_s * jnp.tril(jnp.ones((CHUNK, CHUNK), w_s.dtype))
    mixed = jnp.einsum('gts,bnsgc->bntgc', w, vc) + b_s.T[None, None, :, :, None]
    return u * mixed.reshape(B, S, W)


def mixer_ab(h, w_in, sc_conv_w, w_out):
    B, S, _ = h.shape
    p = h @ w_in
    q, k, v, gate_b, gate_c, hin = jnp.split(
        p, [SB_WIDTH, 2 * SB_WIDTH, 3 * SB_WIDTH,
            3 * SB_WIDTH + SC_WIDTH, 3 * SB_WIDTH + 2 * SC_WIDTH], axis=-1)
    a_out = stick_breaking_attention(split_heads(q, SB_HEADS), split_heads(k, SB_HEADS),
                                     split_heads(v, SB_HEADS)).reshape(B, S, SB_WIDTH)
    b_out = gate_b * causal_dwconv(gate_c * hin, sc_conv_w)
    return jnp.concatenate([a_out, b_out], axis=-1) @ w_out


def mixer_cd(h, w_in, fox_b_f, sg_w, sg_b, sg_norm_g, w_out):
    B, S, _ = h.shape
    p = h @ w_in
    u, v, q, k, vv, f = jnp.split(
        p, [SG_WIDTH, 2 * SG_WIDTH, 2 * SG_WIDTH + FOX_WIDTH,
            2 * SG_WIDTH + 2 * FOX_WIDTH, 2 * SG_WIDTH + 3 * FOX_WIDTH], axis=-1)
    c_out = chunked_spatial_gate(jax.nn.gelu(u), jax.nn.gelu(v), sg_w, sg_b, sg_norm_g)
    log_f = jax.nn.log_sigmoid(f.astype(jnp.float32) + fox_b_f.astype(jnp.float32))
    d_out = forgetting_attention(split_heads(q, FOX_HEADS), split_heads(k, FOX_HEADS),
                                 split_heads(vv, FOX_HEADS), log_f).reshape(B, S, FOX_WIDTH)
    return jnp.concatenate([c_out, d_out], axis=-1) @ w_out


def conv_ffn(h, w_up, conv_w, w_down):
    a = causal_dwconv(h @ w_up, conv_w)
    gate, up = jnp.split(a, 2, axis=-1)
    return (jax.nn.silu(gate) * up) @ w_down


def setup_inputs(seed: int = 0) -> dict:
    key = jax.random.key(seed)
    ks = iter(jax.random.split(key, 32))
    f32 = jnp.float32

    def w(shape, fan_in):
        return jax.random.normal(next(ks), shape, f32) * (fan_in ** -0.5)

    def gain(n):
        return 1.0 + 0.02 * jax.random.normal(next(ks), (n,), f32)

    inp = {}
    inp["x"] = jax.random.normal(next(ks), (BATCH, SEQ, D_MODEL), f32)
    inp["l0_mix_norm_g"] = gain(D_MODEL)
    inp["l0_w_in"] = w((D_MODEL, IN_AB), D_MODEL)
    inp["l0_sc_conv_w"] = w((CONV_WIDTH, SC_WIDTH), CONV_WIDTH)
    inp["l0_w_out"] = w((MIX_WIDTH, D_MODEL), MIX_WIDTH)
    inp["l0_ffn_norm_g"] = gain(D_MODEL)
    inp["l0_ffn_up"] = w((D_MODEL, 2 * D_FF), D_MODEL)
    inp["l0_ffn_conv_w"] = w((CONV_WIDTH, 2 * D_FF), CONV_WIDTH)
    inp["l0_ffn_down"] = w((D_FF, D_MODEL), D_FF)
    inp["l1_mix_norm_g"] = gain(D_MODEL)
    inp["l1_w_in"] = w((D_MODEL, IN_CD), D_MODEL)
    inp["l1_fox_b_f"] = 1.0 + 0.5 * jax.random.normal(next(ks), (FOX_HEADS,), f32)
    inp["l1_sg_w"] = w((SG_GROUPS, CHUNK, CHUNK), CHUNK)
    inp["l1_sg_b"] = 1.0 + 0.1 * jax.random.normal(next(ks), (SG_GROUPS, CHUNK), f32)
    inp["l1_sg_norm_g"] = gain(SG_WIDTH)
    inp["l1_w_out"] = w((MIX_WIDTH, D_MODEL), MIX_WIDTH)
    inp["l1_ffn_norm_g"] = gain(D_MODEL)
    inp["l1_ffn_up"] = w((D_MODEL, 2 * D_FF), D_MODEL)
    inp["l1_ffn_conv_w"] = w((CONV_WIDTH, 2 * D_FF), CONV_WIDTH)
    inp["l1_ffn_down"] = w((D_FF, D_MODEL), D_FF)
    inp["final_norm_g"] = gain(D_MODEL)
    return inp


def reference(x, l0_mix_norm_g, l0_w_in, l0_sc_conv_w, l0_w_out, l0_ffn_norm_g,
              l0_ffn_up, l0_ffn_conv_w, l0_ffn_down,
              l1_mix_norm_g, l1_w_in, l1_fox_b_f, l1_sg_w, l1_sg_b, l1_sg_norm_g,
              l1_w_out, l1_ffn_norm_g, l1_ffn_up, l1_ffn_conv_w, l1_ffn_down,
              final_norm_g):
    layers = [
        (l0_mix_norm_g,
         functools.partial(mixer_ab, w_in=l0_w_in, sc_conv_w=l0_sc_conv_w, w_out=l0_w_out),
         l0_ffn_norm_g, l0_ffn_up, l0_ffn_conv_w, l0_ffn_down),
        (l1_mix_norm_g,
         functools.partial(mixer_cd, w_in=l1_w_in, fox_b_f=l1_fox_b_f, sg_w=l1_sg_w,
                           sg_b=l1_sg_b, sg_norm_g=l1_sg_norm_g, w_out=l1_w_out),
         l1_ffn_norm_g, l1_ffn_up, l1_ffn_conv_w, l1_ffn_down),
    ]
    for i in range(DEPTH):
        mix_g, mixer, ffn_g, w_up, conv_w, w_down = layers[i]
        x = x + mixer(rmsnorm(x, mix_g))
        x = x + conv_ffn(rmsnorm(x, ffn_g), w_up, conv_w, w_down)
    return rmsnorm(x, final_norm_g)
```

```cpp
#include <hip/hip_runtime.h>
#include <hip/hip_cooperative_groups.h>
#include <cstdio>
#include <cstdint>
namespace cg = cooperative_groups;
__device__ __forceinline__ int opaque_tid() { int t = threadIdx.x; asm volatile("" : "+v"(t)); return t; }

namespace pg8 {
#define PG8_LAS __attribute__((address_space(3)))
typedef unsigned short bf16_t;
typedef short bf16x8 __attribute__((ext_vector_type(8)));
typedef float f32x4 __attribute__((ext_vector_type(4)));
typedef float f32x2 __attribute__((ext_vector_type(2)));
typedef unsigned u32x4 __attribute__((ext_vector_type(4)));
typedef unsigned u32x2 __attribute__((ext_vector_type(2)));
constexpr int BM = 256, BK = 64, HALF = 128, HTB = HALF * BK * 2, STAGE_BYTES = 8 * HTB, NXCD = 8, WGM = 8;

__host__ __device__ __forceinline__ int lds_byte(int r, int c) { const int st = (r >> 4) * 2 + (c >> 5), rr = r & 15, cc = c & 31, ob = rr * 64 + cc * 2; return st * 1024 + (ob ^ (((ob >> 9) & 1) << 5)); }
__host__ __device__ __forceinline__ void stage_rc(int b, int& R, int& C) { const int st = b / 1024, sb = b % 1024, swz = sb ^ (((sb >> 9) & 1) << 5); R = (st >> 1) * 16 + swz / 64; C = (st & 1) * 32 + (swz % 64) / 2; }
__host__ __device__ __forceinline__ int perm32(int rho) { const int n = rho >> 4, i = rho & 15; return 8 * (i >> 2) + 4 * n + (i & 3); }

struct Unit { int pm, pn; };
struct Gemm { const bf16_t* A; const bf16_t* Bt; int M, N, K; };

struct StaticOrder {
    int nM, nN, nwg, G, c;
    __host__ __device__ void init(int M, int N, int G_, int c_) { nM = M / BM; nN = N / BM; nwg = nM * nN; G = G_; c = c_; }
    __host__ __device__ bool next(int i, Unit& u) const {
        const long L = (long)i * G + c; if (L >= nwg) return false;
        int wgid = (int)L; { const int q = nwg / NXCD, r = nwg % NXCD, xcd = wgid % NXCD, off = wgid / NXCD; wgid = (xcd < r ? xcd * (q + 1) : r * (q + 1) + (xcd - r) * q) + off; }
        const int nig = WGM * nN, gid = wgid / nig, fm = gid * WGM, gsz = (nM - fm) < WGM ? (nM - fm) : WGM;
        u.pm = fm + ((wgid % nig) % gsz); u.pn = (wgid % nig) / gsz; return true;
    }
    __device__ __forceinline__ void a_ready(const Unit&) const {}
    __device__ __forceinline__ void done(const Unit&) const {}
};

__device__ __forceinline__ unsigned cvt_pk_bf16(float lo, float hi) { unsigned r; asm volatile("v_cvt_pk_bf16_f32 %0, %1, %2" : "=v"(r) : "v"(lo), "v"(hi)); return r; }
__device__ __forceinline__ float gelu_tanh(float x) { const float u2 = 1.5957691216057308f * (x + 0.044715f * x * x * x); return x * __builtin_amdgcn_rcpf(1.0f + __expf(-u2)); }
__device__ __forceinline__ float silu_f(float x) { return x * __builtin_amdgcn_rcpf(1.0f + __expf(-x)); }

struct EpiStore {
    static constexpr bool PERM = true, AFTER_DRAIN = false, INIT = false, HOOK = false, PERMA = false;
    bf16_t* O; int ldc; int gelu_tiles;
    __device__ __forceinline__ void operator()(const f32x4 (&acc)[2][2][4][2], const Unit& u, int wr, int wc, int fr, int fq) const {
        const int row0 = u.pm * BM + wr * 64 + fr; const int col0 = u.pn * BM + wc * 32 + 8 * fq;
        const bool g = u.pn < gelu_tiles;
#pragma unroll
        for (int ai = 0; ai < 2; ++ai)
#pragma unroll
            for (int m = 0; m < 4; ++m) { bf16_t* rowp = O + (size_t)(row0 + ai * HALF + m * 16) * ldc + col0;
#pragma unroll
                for (int bj = 0; bj < 2; ++bj) { f32x4 v0 = acc[ai][bj][m][0], v1 = acc[ai][bj][m][1];
                    if (g) {
#pragma unroll
                        for (int e = 0; e < 4; ++e) { v0[e] = gelu_tanh(v0[e]); v1[e] = gelu_tanh(v1[e]); } }
                    u32x4 w; w.x = cvt_pk_bf16(v0[0], v0[1]); w.y = cvt_pk_bf16(v0[2], v0[3]); w.z = cvt_pk_bf16(v1[0], v1[1]); w.w = cvt_pk_bf16(v1[2], v1[3]);
                    *(u32x4*)(rowp + bj * HALF) = w; }
                if (m & 1) asm volatile("" ::: "memory"); }
    }
};
template <bool NOUT, bool WF32 = true, bool RB16 = false> struct EpiResidT {
    static constexpr bool PERM = false, AFTER_DRAIN = false, INIT = true, HOOK = false, PERMA = false;
    const float* base; float* out; int ldc; bf16_t* xb; float* ssq; const bf16_t* xb16;
    __device__ __forceinline__ void init(f32x4 (&acc)[2][2][4][2], const Unit& u, int wr, int wc, int fr, int fq) const {
        const int col0 = u.pn * BM + wc * 32 + 4 * fq;
#pragma unroll
        for (int ai = 0; ai < 2; ++ai)
#pragma unroll
            for (int m = 0; m < 4; ++m) { const size_t off = (size_t)(u.pm * BM + ai * HALF + wr * 64 + m * 16 + fr) * ldc + col0;
#pragma unroll
                for (int bj = 0; bj < 2; ++bj)
#pragma unroll
                    for (int n = 0; n < 2; ++n) {
                        if (RB16) { const u32x2 w = *(const u32x2*)(xb16 + off + bj * HALF + n * 16); acc[ai][bj][m][n] = (f32x4){__uint_as_float(w.x << 16), __uint_as_float(w.x & 0xffff0000u), __uint_as_float(w.y << 16), __uint_as_float(w.y & 0xffff0000u)}; }
                        else acc[ai][bj][m][n] = *(const f32x4*)(base + off + bj * HALF + n * 16); } }
    }
    __device__ __forceinline__ void operator()(const f32x4 (&acc)[2][2][4][2], const Unit& u, int wr, int wc, int fr, int fq) const {
        const int col0 = u.pn * BM + wc * 32 + 4 * fq;
#pragma unroll
        for (int ai = 0; ai < 2; ++ai)
#pragma unroll
            for (int m = 0; m < 4; ++m) { const int row = u.pm * BM + ai * HALF + wr * 64 + m * 16 + fr; const size_t off = (size_t)row * ldc + col0;
                float sq = 0.f;
#pragma unroll
                for (int bj = 0; bj < 2; ++bj)
#pragma unroll
                    for (int n = 0; n < 2; ++n) { const f32x4 o = acc[ai][bj][m][n]; if (WF32) *(f32x4*)(out + off + bj * HALF + n * 16) = o;
                        if (NOUT) { u32x2 w; w.x = cvt_pk_bf16(o[0], o[1]); w.y = cvt_pk_bf16(o[2], o[3]); *(u32x2*)(xb + off + bj * HALF + n * 16) = w; sq += (o[0] * o[0] + o[1] * o[1]) + (o[2] * o[2] + o[3] * o[3]); } }
                if (NOUT) { sq += __shfl_xor(sq, 16); sq += __shfl_xor(sq, 32); if (fq == 0) ssq[(size_t)row * 32 + u.pn * 4 + wc] = sq; }
                asm volatile("" ::: "memory"); }
    }
};
constexpr int NUPC = 11264, DFFC = 5632;
struct EpiUpConv {
    static constexpr bool PERM = true, AFTER_DRAIN = false, INIT = false, HOOK = true, PERMA = true;
    bf16_t* act; const float* cw; float* side; PG8_LAS float* hal; const float* ssq; PG8_LAS float* rs; PG8_LAS float* cwl2; int pm0;
    __device__ __forceinline__ void begin_unit(const Unit& u, int ui, int wid, int lane) const {
        if (wid < 3) { const float* src = cw + wid * NUPC + (lane >> 5) * DFFC + u.pn * HALF + (lane & 31) * 4;
            __builtin_amdgcn_global_load_lds((const unsigned*)src, (PG8_LAS unsigned*)(cwl2 + (ui & 1) * 768 + wid * 256), 16, 0, 0); }
    }
    __device__ __forceinline__ void operator()(f32x4 (&acc)[2][2][4][2], const Unit& u, int wr, int wc, int fr, int fq, int ui) const {
        const PG8_LAS float* cwl = cwl2 + (ui & 1) * 768;
        if (u.pm != pm0) {
            int l2 = fq * 16 + fr; asm volatile("" : "+v"(l2));
            const int rl = (wr * 4 + wc) * 32 + (l2 & 31), hf = l2 >> 5;
            const float* sp = ssq + (size_t)(u.pm * BM + rl) * 32 + hf * 16;
            const f32x4 a0 = *(const f32x4*)sp, a1 = *(const f32x4*)(sp + 4), a2 = *(const f32x4*)(sp + 8), a3 = *(const f32x4*)(sp + 12);
            float t = ((a0[0] + a0[1]) + (a0[2] + a0[3])) + ((a1[0] + a1[1]) + (a1[2] + a1[3])) + ((a2[0] + a2[1]) + (a2[2] + a2[3])) + ((a3[0] + a3[1]) + (a3[2] + a3[3]));
            t += __shfl_xor(t, 32);
            asm volatile("s_waitcnt lgkmcnt(0)" ::: "memory"); __builtin_amdgcn_s_barrier(); asm volatile("" ::: "memory");
            if (hf == 0) rs[rl] = 1.0f / sqrtf(t * (1.0f / 2048.0f) + 1e-6f);
            asm volatile("s_waitcnt lgkmcnt(0)" ::: "memory"); __builtin_amdgcn_s_barrier(); asm volatile("" ::: "memory");
        }
        {
            int frr = fr; asm volatile("" : "+v"(frr));
            const PG8_LAS float* rp = rs + wr * 64 + 4 * frr;
#pragma unroll
            for (int ai = 0; ai < 2; ++ai)
#pragma unroll
                for (int m = 0; m < 4; ++m) { const float r = rp[ai * HALF + m];
#pragma unroll
                    for (int bj = 0; bj < 2; ++bj)
#pragma unroll
                        for (int n = 0; n < 2; ++n) acc[ai][bj][m][n] = acc[ai][bj][m][n] * r; }
        }
        int cl = wc * 32 + 8 * fq; asm volatile("" : "+v"(cl));
        const PG8_LAS unsigned char* halr = (const PG8_LAS unsigned char*)hal - 2048 + wr * 2048 + cl * 4;
        if (fr == 15) {
            PG8_LAS unsigned char* halw = (PG8_LAS unsigned char*)hal + wr * 2048 + cl * 4;
#pragma unroll
            for (int ai = 0; ai < 2; ++ai) { const int s = 2 * ai + wr;
#pragma unroll
                for (int j = 0; j < 2; ++j)
#pragma unroll
                    for (int bj = 0; bj < 2; ++bj)
#pragma unroll
                        for (int n = 0; n < 2; ++n) { const f32x4 v = acc[ai][bj][2 + j][n];
                            *(PG8_LAS f32x4*)(halw + ai * 4096 + j * 1024 + bj * 512 + n * 16) = v;
                            if (s == 3) *(f32x4*)(side + ((size_t)(u.pm * 4 + 2 + j) * NUPC + u.pn * BM + bj * HALF + cl + 4 * n)) = v; } }
        }
        asm volatile("s_waitcnt lgkmcnt(0)" ::: "memory"); __builtin_amdgcn_s_barrier(); asm volatile("" ::: "memory");
        const int ch0 = u.pn * HALF + cl;
#pragma unroll
        for (int ai = 0; ai < 2; ++ai) { const int s = 2 * ai + wr;
#pragma unroll
            for (int n = 0; n < 2; ++n) {
                unsigned wv[4][2];
#pragma unroll
                for (int ep = 0; ep < 2; ++ep) {
                    float yv[2][4][2];
#pragma unroll
                    for (int bj = 0; bj < 2; ++bj) {
                        const PG8_LAS float* wl = cwl + bj * HALF + cl + 4 * n + 2 * ep;
                        const f32x2 w0 = *(const PG8_LAS f32x2*)(wl), w1 = *(const PG8_LAS f32x2*)(wl + 256), w2 = *(const PG8_LAS f32x2*)(wl + 512);
                        f32x2 H1 = {0.f, 0.f}, H2 = {0.f, 0.f};
                        if (s > 0 && fr == 0) { H1 = *(const PG8_LAS f32x2*)(halr + ai * 4096 + 1024 + bj * 512 + n * 16 + ep * 8); H2 = *(const PG8_LAS f32x2*)(halr + ai * 4096 + bj * 512 + n * 16 + ep * 8); }
#pragma unroll
                        for (int e = 0; e < 2; ++e) {
                            const float a0 = acc[ai][bj][0][n][2 * ep + e], a1 = acc[ai][bj][1][n][2 * ep + e], a2 = acc[ai][bj][2][n][2 * ep + e], a3 = acc[ai][bj][3][n][2 * ep + e];
                            float y0 = w2[e] * a0 + w1[e] * H1[e] + w0[e] * H2[e];
                            float y1 = w2[e] * a1 + w1[e] * a0 + w0[e] * H1[e];
                            const float y2 = w2[e] * a2 + w1[e] * a1 + w0[e] * a0;
                            const float y3 = w2[e] * a3 + w1[e] * a2 + w0[e] * a1;
                            asm volatile("s_nop 1\n\t"
                                         "v_fmac_f32_dpp %0, %3, %4 row_shr:1 row_mask:0xf bank_mask:0xf bound_ctrl:0\n\t"
                                         "v_fmac_f32_dpp %0, %2, %5 row_shr:1 row_mask:0xf bank_mask:0xf bound_ctrl:0\n\t"
                                         "v_fmac_f32_dpp %1, %3, %5 row_shr:1 row_mask:0xf bank_mask:0xf bound_ctrl:0"
                                         : "+v"(y0), "+v"(y1)
                                         : "v"(a2), "v"(a3), "v"(w1[e]), "v"(w0[e]));
                            yv[bj][0][e] = y0; yv[bj][1][e] = y1; yv[bj][2][e] = y2; yv[bj][3][e] = y3;
                        }
                    }
#pragma unroll
                    for (int m = 0; m < 4; ++m) {
                        wv[m][ep] = cvt_pk_bf16(silu_f(yv[0][m][0]) * yv[1][m][0], silu_f(yv[0][m][1]) * yv[1][m][1]);
                        if (m < 2 && s == 0 && fr == 0) {
                            *(f32x2*)(side + ((size_t)(u.pm * 4 + m) * NUPC + u.pn * BM + cl + 4 * n + 2 * ep)) = (f32x2){yv[0][m][0], yv[0][m][1]};
                            *(f32x2*)(side + ((size_t)(u.pm * 4 + m) * NUPC + u.pn * BM + HALF + cl + 4 * n + 2 * ep)) = (f32x2){yv[1][m][0], yv[1][m][1]}; }
                    }
                    asm volatile("" ::: "memory"); __builtin_amdgcn_sched_barrier(0);
                }
#pragma unroll
                for (int m = 0; m < 4; ++m) {
                    const int row = u.pm * BM + ai * HALF + wr * 64 + 4 * fr + m;
                    u32x2 w; w.x = wv[m][0]; w.y = wv[m][1];
                    *(u32x2*)(act + (size_t)row * DFFC + ch0 + 4 * n) = w;
                }
                asm volatile("" ::: "memory"); __builtin_amdgcn_sched_barrier(0);
            }
        }
    }
};

template <class Epi, class Sched, bool ALIGN_EPI = false, bool SP2 = false>
__device__ __forceinline__ void gemm_phase(PG8_LAS unsigned char* lds, const Gemm g, const Sched& S, const Epi& E) {
    const int tid = opaque_tid(), wid = __builtin_amdgcn_readfirstlane(tid >> 6), lane = tid & 63, wr = wid >> 2, wc = wid & 3, fr = lane & 15, fq = lane >> 4;
    const int K = g.K, nt = K / BK;
    unsigned voffA[2], voffB[2];
#pragma unroll
    for (int i = 0; i < 2; ++i) { int R, C; stage_rc(tid * 16 + i * 8192, R, C); const int Rb = Epi::PERM ? ((R & ~31) + perm32(R & 31)) : R;
        const int Ra = Epi::PERMA ? ((R & ~63) + 4 * (R & 15) + ((R >> 4) & 3)) : R;
        voffA[i] = (unsigned)(Ra * K + C) * 2u; voffB[i] = (unsigned)(Rb * K + C) * 2u; }
    const size_t kstep = (size_t)(BK * 2);
    const size_t hstep = (size_t)HALF * K * 2;
    const size_t tstep = 2 * hstep;
    const unsigned ldsw = (unsigned)wid * 1024u;
    const int aoff = lds_byte(wr * 64 + fr, fq * 8), boff = lds_byte(wc * 32 + fr, fq * 8);
#define PG8_SA(b, h) (((b) * 2 + (h)) * HTB)
#define PG8_SB(b, h) ((4 + (b) * 2 + (h)) * HTB)
#define PG8_STAGE(bufoff, gbase, voff) do { _Pragma("unroll") for (int _i = 0; _i < 2; ++_i) \
        __builtin_amdgcn_global_load_lds((const unsigned*)((const char*)(gbase) + (voff)[_i]), (PG8_LAS unsigned*)(lds + (bufoff) + ldsw + _i * 8192), 16, 0, 0); } while (0)
#define PG8_LDA(dst, b, h) do { _Pragma("unroll") for (int m = 0; m < 4; ++m) _Pragma("unroll") for (int k = 0; k < 2; ++k) dst[m][k] = *(const PG8_LAS bf16x8*)(lds + PG8_SA(b, h) + aoff + m * 2048 + k * 1024); } while (0)
#define PG8_LDB(dst, b, h) do { _Pragma("unroll") for (int n = 0; n < 2; ++n) _Pragma("unroll") for (int k = 0; k < 2; ++k) dst[n][k] = *(const PG8_LAS bf16x8*)(lds + PG8_SB(b, h) + boff + n * 2048 + k * 1024); } while (0)
#define PG8_MMA(ai, bj, At, Bt) do { __builtin_amdgcn_s_setprio(3); _Pragma("unroll") for (int m = 0; m < 4; ++m) _Pragma("unroll") for (int n = 0; n < 2; ++n) _Pragma("unroll") for (int k = 0; k < 2; ++k) \
        acc[ai][bj][m][n] = __builtin_amdgcn_mfma_f32_16x16x32_bf16(Bt[n][k], At[m][k], acc[ai][bj][m][n], 0, 0, 0); __builtin_amdgcn_s_setprio(0); } while (0)
#define PG8_WAIT_V(n) asm volatile("s_waitcnt vmcnt(" #n ")" ::: "memory")
#define PG8_WAIT_L(n) asm volatile("s_waitcnt lgkmcnt(" #n ")" ::: "memory")
#define PG8_BAR __builtin_amdgcn_s_barrier()
#define PG8_SCHED __builtin_amdgcn_sched_barrier(0)
    Unit cur, nxt; int ui = 0;
    if (!S.next(0, cur)) return;
    f32x4 acc[2][2][4][2];
    if constexpr (Epi::HOOK) E.begin_unit(cur, 0, wid, lane);
    if constexpr (Epi::INIT) E.init(acc, cur, wr, wc, fr, fq);
    else {
#pragma unroll
    for (int a = 0; a < 2; ++a)
#pragma unroll
        for (int b = 0; b < 2; ++b)
#pragma unroll
            for (int m = 0; m < 4; ++m)
#pragma unroll
                for (int n = 0; n < 2; ++n) acc[a][b][m][n] = (f32x4){0.f, 0.f, 0.f, 0.f};
    }
    bf16x8 At[4][2], B0[2][2], B1[2][2];
    const char* cA = (const char*)g.A + (size_t)cur.pm * tstep; const char* cB = (const char*)g.Bt + (size_t)cur.pn * tstep;
    S.a_ready(cur);
    if constexpr (SP2) {
        PG8_STAGE(PG8_SB(0, 0), cB, voffB); PG8_STAGE(PG8_SB(0, 1), cB + hstep, voffB); PG8_STAGE(PG8_SA(0, 0), cA, voffA); PG8_STAGE(PG8_SA(0, 1), cA + hstep, voffA);
        if (wr == 1) PG8_BAR;
        PG8_WAIT_V(2); PG8_BAR;
        PG8_STAGE(PG8_SB(1, 0), cB + kstep, voffB); PG8_STAGE(PG8_SA(1, 0), cA + kstep, voffA); PG8_STAGE(PG8_SB(1, 1), cB + hstep + kstep, voffB);
        PG8_WAIT_V(6); PG8_BAR;
    } else {
        PG8_STAGE(PG8_SB(0, 0), cB, voffB); PG8_STAGE(PG8_SA(0, 0), cA, voffA); PG8_STAGE(PG8_SB(0, 1), cB + hstep, voffB); PG8_STAGE(PG8_SA(0, 1), cA + hstep, voffA);
        if (wr == 1) PG8_BAR;
        PG8_WAIT_V(4); PG8_BAR;
        PG8_STAGE(PG8_SB(1, 0), cB + kstep, voffB); PG8_STAGE(PG8_SA(1, 0), cA + kstep, voffA); PG8_STAGE(PG8_SB(1, 1), cB + hstep + kstep, voffB);
        PG8_WAIT_V(6); PG8_BAR;
    }
    for (;;) {
        const bool has_next = S.next(ui + 1, nxt);
        const char* nA = has_next ? (const char*)g.A + (size_t)nxt.pm * tstep : cA; const char* nB = has_next ? (const char*)g.Bt + (size_t)nxt.pn * tstep : cB;
        for (int t = 0; t < nt; t += 2) {
            const bool last = (t == nt - 2);
            const char* a1 = cA + (size_t)(t + 1) * kstep;
            const char* a2 = last ? nA : cA + (size_t)(t + 2) * kstep; const char* b2 = last ? nB : cB + (size_t)(t + 2) * kstep;
            const char* a3 = a2 + kstep; const char* b3 = b2 + kstep;
            if (last && has_next) S.a_ready(nxt);
            if constexpr (SP2) {
            PG8_LDB(B0, 0, 0); PG8_LDB(B1, 0, 1); PG8_SCHED; PG8_LDA(At, 0, 0); PG8_STAGE(PG8_SA(1, 1), a1 + hstep, voffA);
            PG8_WAIT_V(8); PG8_WAIT_L(0); PG8_BAR; PG8_MMA(0, 0, At, B0); PG8_MMA(0, 1, At, B1); PG8_BAR; PG8_SCHED;
            PG8_LDA(At, 0, 1); PG8_STAGE(PG8_SB(0, 0), b2, voffB); PG8_STAGE(PG8_SB(0, 1), b2 + hstep, voffB); PG8_STAGE(PG8_SA(0, 0), a2, voffA);
            PG8_WAIT_V(8); PG8_WAIT_L(0); PG8_BAR; PG8_MMA(1, 0, At, B0); PG8_MMA(1, 1, At, B1); PG8_BAR; PG8_SCHED;
            PG8_LDB(B0, 1, 0); PG8_LDB(B1, 1, 1); PG8_SCHED; PG8_LDA(At, 1, 0); PG8_STAGE(PG8_SA(0, 1), a2 + hstep, voffA);
            PG8_WAIT_V(8); PG8_WAIT_L(0); PG8_BAR; PG8_MMA(0, 0, At, B0); PG8_MMA(0, 1, At, B1); PG8_BAR; PG8_SCHED;
            PG8_LDA(At, 1, 1); PG8_STAGE(PG8_SB(1, 0), b3, voffB); PG8_STAGE(PG8_SB(1, 1), b3 + hstep, voffB); PG8_STAGE(PG8_SA(1, 0), a3, voffA);
            PG8_WAIT_V(8); PG8_WAIT_L(0); PG8_BAR; PG8_MMA(1, 0, At, B0); PG8_MMA(1, 1, At, B1); PG8_BAR; PG8_SCHED;
            } else {
            PG8_LDB(B0, 0, 0); PG8_SCHED; PG8_LDA(At, 0, 0); PG8_STAGE(PG8_SA(1, 1), a1 + hstep, voffA);
            PG8_WAIT_L(8); PG8_BAR; PG8_WAIT_L(0); PG8_MMA(0, 0, At, B0); PG8_BAR; PG8_SCHED;
            PG8_LDB(B1, 0, 1); PG8_STAGE(PG8_SB(0, 0), b2, voffB);
            PG8_BAR; PG8_WAIT_L(0); PG8_MMA(0, 1, At, B1); PG8_BAR;
            PG8_LDA(At, 0, 1); PG8_STAGE(PG8_SA(0, 0), a2, voffA);
            PG8_BAR; PG8_WAIT_L(0); PG8_MMA(1, 0, At, B0); PG8_BAR; PG8_SCHED;
            PG8_STAGE(PG8_SB(0, 1), b2 + hstep, voffB);
            PG8_WAIT_V(6); PG8_BAR; PG8_MMA(1, 1, At, B1); PG8_BAR;
            PG8_LDB(B0, 1, 0); PG8_SCHED; PG8_LDA(At, 1, 0); PG8_STAGE(PG8_SA(0, 1), a2 + hstep, voffA);
            PG8_WAIT_L(8); PG8_BAR; PG8_WAIT_L(0); PG8_MMA(0, 0, At, B0); PG8_BAR; PG8_SCHED;
            PG8_LDB(B1, 1, 1); PG8_STAGE(PG8_SB(1, 0), b3, voffB);
            PG8_BAR; PG8_WAIT_L(0); PG8_MMA(0, 1, At, B1); PG8_BAR;
            PG8_LDA(At, 1, 1); PG8_STAGE(PG8_SA(1, 0), a3, voffA);
            PG8_BAR; PG8_WAIT_L(0); PG8_MMA(1, 0, At, B0); PG8_BAR; PG8_SCHED;
            PG8_STAGE(PG8_SB(1, 1), b3 + hstep, voffB);
            PG8_WAIT_V(6); PG8_BAR; PG8_MMA(1, 1, At, B1); PG8_BAR;
            }
        }
        if constexpr (ALIGN_EPI) { if (wr == 0) PG8_BAR; }
        if constexpr (!Epi::AFTER_DRAIN) { if constexpr (Epi::HOOK) E(acc, cur, wr, wc, fr, fq, ui); else E(acc, cur, wr, wc, fr, fq); S.done(cur); }
        if (!has_next) break;
        if constexpr (Epi::HOOK) E.begin_unit(nxt, ui + 1, wid, lane);
        if constexpr (Epi::INIT) E.init(acc, nxt, wr, wc, fr, fq);
        else {
#pragma unroll
        for (int a = 0; a < 2; ++a)
#pragma unroll
            for (int b = 0; b < 2; ++b)
#pragma unroll
                for (int m = 0; m < 4; ++m)
#pragma unroll
                    for (int n = 0; n < 2; ++n) acc[a][b][m][n] = (f32x4){0.f, 0.f, 0.f, 0.f};
        }
        cur = nxt; cA = nA; cB = nB; ++ui;
        if constexpr (ALIGN_EPI) { if (wr == 1) PG8_BAR; }
    }
    PG8_WAIT_V(0);
    if constexpr (!ALIGN_EPI) { if (wr == 0) PG8_BAR; }
    PG8_BAR;
#undef PG8_SA
#undef PG8_SB
#undef PG8_STAGE
#undef PG8_LDA
#undef PG8_LDB
#undef PG8_MMA
#undef PG8_WAIT_V
#undef PG8_WAIT_L
#undef PG8_BAR
#undef PG8_SCHED
}
}

#define LAS __attribute__((address_space(3)))
typedef unsigned short bf16;
typedef short bf16x8 __attribute__((ext_vector_type(8)));
typedef float f32x4 __attribute__((ext_vector_type(4)));
typedef float f32x2 __attribute__((ext_vector_type(2)));
typedef float f32x16 __attribute__((ext_vector_type(16)));
typedef unsigned u32x4 __attribute__((ext_vector_type(4)));
typedef unsigned u32x2 __attribute__((ext_vector_type(2)));
typedef __bf16 bf16x2_t __attribute__((ext_vector_type(2)));

constexpr int SEQ = 2048, BATCH = 8, DM = 2048, M = BATCH * SEQ, DFF = 5632, NUP = 2 * DFF, NIN0 = 6144, NIN1 = 5120, LDW1 = 5128;
constexpr float EPS = 1e-6f;
constexpr float ATT_SCALE = 0.08838834764831845f;
constexpr size_t MiB = 1u << 20;
constexpr size_t WS_FLOG = 1 * MiB, WS_SIDE = 2 * MiB;
constexpr size_t WS_WIN0 = 16 * MiB, WS_WOUT0 = 40 * MiB, WS_WUP0 = 48 * MiB, WS_WDN0 = 92 * MiB;
constexpr size_t WS_WIN1 = 114 * MiB, WS_WOUT1 = 134 * MiB, WS_WUP1 = 142 * MiB, WS_WDN1 = 186 * MiB;
constexpr size_t WS_H = 208 * MiB;
constexpr size_t WS_P = 272 * MiB;
constexpr size_t WS_HB2 = 448 * MiB;
constexpr size_t WS_SSQ = 14 * MiB;
constexpr size_t WS_END = 512 * MiB;
constexpr int LDS_BYTES = 147456, HAL_OFF = 131072, MISC_OFF = HAL_OFF + 8192;
constexpr size_t CTL_ZERO_BYTES = 16384;

struct Params { const float* in[21]; float* out; unsigned char* ws; };

__device__ __forceinline__ unsigned pk2(float lo, float hi) { f32x2 v = {lo, hi}; bf16x2_t b = __builtin_convertvector(v, bf16x2_t); return __builtin_bit_cast(unsigned, b); }
__device__ __forceinline__ float bf2f(unsigned short b) { return __uint_as_float((unsigned)b << 16); }
__device__ __forceinline__ float bflo(unsigned w) { return __uint_as_float(w << 16); }
__device__ __forceinline__ float bfhi(unsigned w) { return __uint_as_float(w & 0xffff0000u); }
__device__ __forceinline__ float wave_sum(float v) {
#pragma unroll
    for (int o = 1; o < 64; o <<= 1) v += __shfl_xor(v, o);
    return v;
}
__device__ __forceinline__ int crow(int r, int hi) { return (r & 3) + 8 * (r >> 2) + 4 * hi; }
#define MFMA32(a, b, c) __builtin_amdgcn_mfma_f32_32x32x16_bf16((a), (b), (c), 0, 0, 0)


#define XB_TMO      128
#define XB_XCNT(j)  (256  + 64 * (j))
#define XB_XSUB(j)  (1280 + 64 * (j))
#define XB_XGEN(j)  (2304 + 64 * (j))
#define XB_TOP      3328
#define XB_TOPGEN   3392
#define XCD_BAR_WORDS 3456
#define XB_SPIN_CAP (1u << 30)
__device__ __forceinline__ unsigned xb_ld(unsigned* p)              { return __hip_atomic_load(p, __ATOMIC_RELAXED, __HIP_MEMORY_SCOPE_AGENT); }
__device__ __forceinline__ unsigned xb_add(unsigned* p, unsigned v) { return __hip_atomic_fetch_add(p, v, __ATOMIC_RELAXED, __HIP_MEMORY_SCOPE_AGENT); }
__device__ __forceinline__ unsigned xb_xcc_id() { return (unsigned)__builtin_amdgcn_s_getreg((3 << 11) | 20) & 0xFu; }
#define XB_SPIN(cond, bar) do { unsigned _sp = 0; while (cond) { __builtin_amdgcn_s_sleep(1); \
    if ((++_sp & 255u) == 0u) { if (xb_ld(&(bar)[XB_TMO])) break; if (_sp > XB_SPIN_CAP) { atomicAdd(&(bar)[XB_TMO], 1u); break; } } } } while (0)
struct XcdBarrier { unsigned* bar; unsigned x; volatile LAS unsigned* st; };
__device__ __forceinline__ XcdBarrier xcd_barrier_post(unsigned* bar, volatile LAS unsigned* st) {
    XcdBarrier b; b.bar = bar; b.x = xb_xcc_id(); b.st = st;
    if (threadIdx.x == 0) (void)xb_add(&bar[XB_XCNT(b.x)], 1u);
    return b;
}
__device__ __forceinline__ void xcd_barrier_complete(unsigned* bar, unsigned x, unsigned& nloc, unsigned& nx) {
    const unsigned G = gridDim.x * gridDim.y * gridDim.z;
    unsigned sum, cnt, mine, sp = 0u;
    for (;;) {
        sum = 0u; cnt = 0u; mine = 0u;
#pragma unroll
        for (unsigned j = 0; j < 16; ++j) { const unsigned c = xb_ld(&bar[XB_XCNT(j)]); sum += c; cnt += (c > 0u) ? 1u : 0u; mine = (j == x) ? c : mine; }
        if (sum == G) break;
        __builtin_amdgcn_s_sleep(1);
        if ((++sp & 255u) == 0u) { if (xb_ld(&bar[XB_TMO])) break; if (sp > XB_SPIN_CAP) { atomicAdd(&bar[XB_TMO], 1u); break; } }
    }
    nloc = mine > 0u ? mine : 1u; nx = cnt > 0u ? cnt : 1u;
}
__device__ __forceinline__ void xcd_barrier(const XcdBarrier& b) {
    asm volatile("s_waitcnt vmcnt(0)" ::: "memory");
    __syncthreads();
    if (threadIdx.x == 0) {
        unsigned* bar = b.bar;
        __builtin_amdgcn_s_waitcnt(0);
        unsigned nloc = b.st[0], nx = b.st[1];
        if (nloc == 0u) { xcd_barrier_complete(bar, b.x, nloc, nx); b.st[0] = nloc; b.st[1] = nx; }
        const unsigned old = xb_add(&bar[XB_XSUB(b.x)], 1u);
        const unsigned gen = old / nloc;
        if (old + 1u == (gen + 1u) * nloc) {
            __builtin_amdgcn_fence(__ATOMIC_RELEASE, "agent");
            asm volatile("s_waitcnt vmcnt(0)" ::: "memory");
            const unsigned og = xb_add(&bar[XB_TOP], 1u);
            const unsigned tg = og / nx;
            if (og + 1u == (tg + 1u) * nx) xb_add(&bar[XB_TOPGEN], 1u);
            else XB_SPIN(xb_ld(&bar[XB_TOPGEN]) == tg, bar);
            __builtin_amdgcn_fence(__ATOMIC_ACQUIRE, "agent");
            xb_add(&bar[XB_XGEN(b.x)], 1u);
            asm volatile("s_waitcnt vmcnt(0)" ::: "memory");
        } else {
            XB_SPIN(xb_ld(&bar[XB_XGEN(b.x)]) == gen, bar);
            __builtin_amdgcn_fence(__ATOMIC_ACQUIRE, "agent");
            asm volatile("s_waitcnt vmcnt(0)" ::: "memory");
        }
    }
    __syncthreads();
}


__device__ __forceinline__ void ctr_barrier(unsigned* cnt, unsigned target) {
    asm volatile("s_waitcnt vmcnt(0)" ::: "memory");
    __syncthreads();
    if (threadIdx.x == 0) {
        __builtin_amdgcn_fence(__ATOMIC_RELEASE, "agent");
        asm volatile("s_waitcnt vmcnt(0)" ::: "memory");
        (void)__hip_atomic_fetch_add(cnt, 1u, __ATOMIC_RELAXED, __HIP_MEMORY_SCOPE_AGENT);
        while (__hip_atomic_load(cnt, __ATOMIC_RELAXED, __HIP_MEMORY_SCOPE_AGENT) < target) __builtin_amdgcn_s_sleep(1);
        __builtin_amdgcn_fence(__ATOMIC_ACQUIRE, "agent");
        asm volatile("s_waitcnt vmcnt(0)" ::: "memory");
    }
    __syncthreads();
}

template <int MAP>
__device__ __forceinline__ void transpose_item(const float* __restrict__ W, int K, int ldw, int nblk, bf16* __restrict__ WT, LAS float* scr, int item, int lane, const float* __restrict__ gk = nullptr) {
    const int kb = item / nblk, nb = item % nblk, k0 = 64 * kb, n0 = 32 * nb;
#pragma unroll 8
    for (int i = 0; i < 8; ++i) { const int kk = 8 * i + (lane >> 3), n4 = (lane & 7) * 4; f32x4 w = *(const f32x4*)(W + (size_t)(k0 + kk) * ldw + n0 + n4); if (MAP == 1) w = w * gk[k0 + kk];
        scr[kk * 33 + n4] = w[0]; scr[kk * 33 + n4 + 1] = w[1]; scr[kk * 33 + n4 + 2] = w[2]; scr[kk * 33 + n4 + 3] = w[3]; }
    asm volatile("s_waitcnt lgkmcnt(0)" ::: "memory");
    int rb = n0;
    if (MAP == 1) { rb = (n0 < DFF) ? ((n0 >> 7) * 256 + (n0 & 127)) : ((((n0 - DFF) >> 7) * 256) + 128 + ((n0 - DFF) & 127)); }
    const int c = lane & 7;
#pragma unroll
    for (int j = 0; j < 4; ++j) { const int n = (lane >> 3) + 8 * j; const LAS float* s = scr + (8 * c) * 33 + n;
        u32x4 o; o.x = pk2(s[0 * 33], s[1 * 33]); o.y = pk2(s[2 * 33], s[3 * 33]); o.z = pk2(s[4 * 33], s[5 * 33]); o.w = pk2(s[6 * 33], s[7 * 33]);
        *(u32x4*)(WT + (size_t)(rb + n) * K + k0 + 8 * c) = o; }
    asm volatile("s_waitcnt lgkmcnt(0)" ::: "memory");
}

template <int MODE>
__device__ __forceinline__ void rms_rows(const float* X, const float* __restrict__ g, bf16* H, float* OutF, const LAS float* WfT, float* flog, int gw, int ngw, int lane) {
    f32x4 gv[8];
#pragma unroll
    for (int j = 0; j < 8; ++j) gv[j] = ((const f32x4*)g)[64 * j + lane];
    for (int m = gw; m < M; m += ngw) {
        const f32x4* xr = (const f32x4*)(X + (size_t)m * DM) + lane;
        f32x4 v[8]; float ss = 0.f;
#pragma unroll
        for (int j = 0; j < 8; ++j) { v[j] = xr[64 * j]; ss += (v[j].x * v[j].x + v[j].y * v[j].y) + (v[j].z * v[j].z + v[j].w * v[j].w); }
        const float rs = 1.0f / sqrtf(wave_sum(ss) * (1.0f / DM) + EPS);
#pragma unroll
        for (int j = 0; j < 8; ++j) v[j] = v[j] * rs * gv[j];
        if (MODE == 2) {
            f32x4* o = (f32x4*)(OutF + (size_t)m * DM) + lane;
#pragma unroll
            for (int j = 0; j < 8; ++j) o[64 * j] = v[j];
        } else {
            u32x2* o = (u32x2*)(H + (size_t)m * DM) + lane;
#pragma unroll
            for (int j = 0; j < 8; ++j) { u32x2 w; w.x = pk2(v[j].x, v[j].y); w.y = pk2(v[j].z, v[j].w); o[64 * j] = w; }
        }
        if (MODE == 1) {
            float a8[8];
#pragma unroll
            for (int jj = 0; jj < 8; ++jj) a8[jj] = 0.f;
#pragma unroll
            for (int j = 0; j < 8; ++j) {
#pragma unroll
                for (int jj = 0; jj < 8; ++jj) { const f32x4 w = *(const LAS f32x4*)(WfT + jj * DM + 4 * (64 * j + lane)); a8[jj] += (v[j].x * w.x + v[j].y * w.y) + (v[j].z * w.z + v[j].w * w.w); }
                asm volatile("" ::: "memory");
            }
            float mine = 0.f;
#pragma unroll
            for (int jj = 0; jj < 8; ++jj) { const float a = wave_sum(a8[jj]); if (lane == jj) mine = a; }
            if (lane < 8) flog[(size_t)m * 8 + lane] = mine;
        }
    }
}

__device__ __forceinline__ void rms1_rows_bf16(const bf16* Xb, const float* __restrict__ ssq, const float* __restrict__ g, bf16* H, const LAS float* WfT, float* flog, int gw, int ngw, int lane) {
    f32x4 gv[8];
#pragma unroll
    for (int j = 0; j < 8; ++j) gv[j] = ((const f32x4*)g)[64 * j + lane];
    for (int m = gw; m < M; m += ngw) {
        const float part = (lane < 32) ? ssq[(size_t)m * 32 + lane] : 0.f;
        const u32x2* xr = (const u32x2*)(Xb + (size_t)m * DM) + lane;
        u32x2 xv[8];
#pragma unroll
        for (int j = 0; j < 8; ++j) xv[j] = xr[64 * j];
        const float rs = 1.0f / sqrtf(wave_sum(part) * (1.0f / DM) + EPS);
        f32x4 v[8];
#pragma unroll
        for (int j = 0; j < 8; ++j) { v[j].x = bflo(xv[j].x); v[j].y = bfhi(xv[j].x); v[j].z = bflo(xv[j].y); v[j].w = bfhi(xv[j].y); v[j] = v[j] * rs * gv[j]; }
        u32x2* o = (u32x2*)(H + (size_t)m * DM) + lane;
#pragma unroll
        for (int j = 0; j < 8; ++j) { u32x2 w; w.x = pk2(v[j].x, v[j].y); w.y = pk2(v[j].z, v[j].w); o[64 * j] = w; }
        float a8[8];
#pragma unroll
        for (int jj = 0; jj < 8; ++jj) a8[jj] = 0.f;
#pragma unroll
        for (int j = 0; j < 8; ++j) {
#pragma unroll
            for (int jj = 0; jj < 8; ++jj) { const f32x4 w = *(const LAS f32x4*)(WfT + jj * DM + 4 * (64 * j + lane)); a8[jj] += (v[j].x * w.x + v[j].y * w.y) + (v[j].z * w.z + v[j].w * w.w); }
            asm volatile("" ::: "memory");
        }
        float mine;
        {
            const bool b2 = (lane & 4) != 0, b1 = (lane & 2) != 0, b0 = (lane & 1) != 0;
            float bq[4], cq[2];
#pragma unroll
            for (int i = 0; i < 4; ++i) { const float snd = b2 ? a8[i] : a8[i + 4]; const float rcv = __shfl_xor(snd, 4); bq[i] = (b2 ? a8[i + 4] : a8[i]) + rcv; }
#pragma unroll
            for (int i = 0; i < 2; ++i) { const float snd = b1 ? bq[i] : bq[i + 2]; const float rcv = __shfl_xor(snd, 2); cq[i] = (b1 ? bq[i + 2] : bq[i]) + rcv; }
            { const float snd = b0 ? cq[0] : cq[1]; const float rcv = __shfl_xor(snd, 1); mine = (b0 ? cq[1] : cq[0]) + rcv; }
            mine += __shfl_xor(mine, 8); mine += __shfl_xor(mine, 16); mine += __shfl_xor(mine, 32);
        }
        if (lane < 8) flog[(size_t)m * 8 + lane] = mine;
    }
}

constexpr int KS_PITCH = 272, VT_PITCH = 144, KBUF = 64 * KS_PITCH, VBUF = 128 * VT_PITCH, KS_OFF = 0, VT_OFF = 2 * KBUF, CS_OFF = VT_OFF + 2 * VBUF, SCAN_OFF = CS_OFF + 8192;
struct KVRegs { u32x4 k[2]; u32x4 v[2]; };
__device__ __forceinline__ void kv_load(KVRegs& R, const bf16* Kg, const bf16* Vg, int ldp, int tid) {
#pragma unroll
    for (int i = 0; i < 2; ++i) { const int c = tid + 512 * i; R.k[i] = *(const u32x4*)(Kg + (size_t)(c >> 4) * ldp + (c & 15) * 8); }
    const int kp = tid & 31, dg = tid >> 5;
    R.v[0] = *(const u32x4*)(Vg + (size_t)(2 * kp) * ldp + dg * 8); R.v[1] = *(const u32x4*)(Vg + (size_t)(2 * kp + 1) * ldp + dg * 8);
}
__device__ __forceinline__ void kv_store(const KVRegs& R, LAS unsigned char* lds, int tid, int buf) {
#pragma unroll
    for (int i = 0; i < 2; ++i) { const int c = tid + 512 * i; *(LAS u32x4*)(lds + KS_OFF + buf * KBUF + (c >> 4) * KS_PITCH + (c & 15) * 16) = R.k[i]; }
    const int kp = tid & 31, dg = tid >> 5;
    const int kk_ = (2 * kp) & 15, g_ = kk_ >> 2, vpos = (((2 * kp) >> 4) * 16 + ((((g_ & 1) << 1) | (g_ >> 1)) * 4) + (kk_ & 3)) * 2;
#pragma unroll
    for (int i = 0; i < 8; ++i) { const unsigned a = (R.v[0][i >> 1] >> (16 * (i & 1))) & 0xffffu, b = (R.v[1][i >> 1] >> (16 * (i & 1))) & 0xffffu;
        *(LAS unsigned*)(lds + VT_OFF + buf * VBUF + (dg * 8 + i) * VT_PITCH + vpos) = a | (b << 16); }
}
__device__ __forceinline__ bf16x8 pack8(const f32x16& x, int s8) {
    u32x4 p; p.x = pk2(x[s8], x[s8 + 1]); p.y = pk2(x[s8 + 2], x[s8 + 3]); p.z = pk2(x[s8 + 4], x[s8 + 5]); p.w = pk2(x[s8 + 6], x[s8 + 7]);
    return __builtin_bit_cast(bf16x8, p);
}
__device__ __forceinline__ void pv_tile(f32x16 (&o)[4], const f32x16& p0, const f32x16& p1, const LAS unsigned char* vbase, int r32, int hh) {
    bf16x8 pf[4]; pf[0] = pack8(p0, 0); pf[1] = pack8(p0, 8); pf[2] = pack8(p1, 0); pf[3] = pack8(p1, 8);
#pragma unroll
    for (int db = 0; db < 4; ++db)
#pragma unroll
        for (int s = 0; s < 4; ++s) {
            const bf16x8 a = *(const LAS bf16x8*)(vbase + (db * 32 + r32) * VT_PITCH + (16 * s + 8 * hh) * 2);
            o[db] = MFMA32(a, pf[s], o[db]);
        }
}
__device__ __forceinline__ void qk_tile(f32x16& s0, f32x16& s1, const bf16x8 (&qf)[8], const LAS unsigned char* kbase, int r32, int hh) {
#pragma unroll
    for (int dh = 0; dh < 2; ++dh) {
        bf16x8 k0[4], k1[4];
#pragma unroll
        for (int d = 0; d < 4; ++d) { const int d0 = 4 * dh + d; k0[d] = *(const LAS bf16x8*)(kbase + r32 * KS_PITCH + d0 * 32 + hh * 16); k1[d] = *(const LAS bf16x8*)(kbase + (32 + r32) * KS_PITCH + d0 * 32 + hh * 16); }
        asm volatile("" ::: "memory");
#pragma unroll
        for (int d = 0; d < 4; ++d) { s0 = MFMA32(k0[d], qf[4 * dh + d], s0); s1 = MFMA32(k1[d], qf[4 * dh + d], s1); }
    }
}

constexpr float QSCALE2 = ATT_SCALE * 1.4426950408889634f, LOG2E = 1.4426950408889634f;
template <int MODE>
__device__ __forceinline__ void attn_item(LAS unsigned char* lds, const bf16* __restrict__ P, int ldp, int qoff, int koff, int voff, bf16* __restrict__ cat, int catoff,
                                          int b, int h, int qb, const float* __restrict__ flog, float bfh) {
    const int tid = opaque_tid(), lane = tid & 63, wid = __builtin_amdgcn_readfirstlane(tid >> 6), r32 = lane & 31, hh = lane >> 5;
    const size_t rowbase = (size_t)b * SEQ; const int q0 = qb * 256;
    const int t = q0 + wid * 32 + r32;
    const int wtmin = q0 + wid * 32, wtmax = wtmin + 31;
    LAS float* cs = (LAS float*)(lds + CS_OFF);
    __syncthreads();
    if (MODE == 1) {
        LAS float* sc = (LAS float*)(lds + SCAN_OFF);
        float v[4]; float run = 0.f;
#pragma unroll
        for (int i = 0; i < 4; ++i) { const float x = flog[(rowbase + tid * 4 + i) * 8 + h] + bfh; const float lf = fminf(x, 0.f) - __logf(1.0f + __expf(-fabsf(x))); run += lf; v[i] = run; }
        float incl = run;
#pragma unroll
        for (int o = 1; o < 64; o <<= 1) { const float y = __shfl_up(incl, o); if (lane >= o) incl += y; }
        if (lane == 63) sc[wid] = incl;
        __syncthreads();
        float base = incl - run;
        for (int w = 0; w < wid; ++w) base += sc[w];
#pragma unroll
        for (int i = 0; i < 4; ++i) cs[tid * 4 + i] = (base + v[i]) * LOG2E;
        __syncthreads();
    }
    bf16x8 qf[8];
    { const bf16* qp = P + (rowbase + t) * ldp + qoff + h * 128 + hh * 8;
#pragma unroll
      for (int d0 = 0; d0 < 8; ++d0) { const u32x4 q = *(const u32x4*)(qp + d0 * 16); u32x4 w;
#pragma unroll
          for (int e = 0; e < 4; ++e) w[e] = pk2(bflo(q[e]) * QSCALE2, bfhi(q[e]) * QSCALE2);
          qf[d0] = __builtin_bit_cast(bf16x8, w); } }
    f32x16 o[4];
#pragma unroll
    for (int db = 0; db < 4; ++db)
#pragma unroll
        for (int i = 0; i < 16; ++i) o[db][i] = 0.f;
    const bf16* Kh = P + rowbase * ldp + koff + h * 128; const bf16* Vh = P + rowbase * ldp + voff + h * 128;
    const int ntiles = (q0 + 256) / 64;
    float carry = 1.f;
    LAS unsigned* flg = (LAS unsigned*)(lds + SCAN_OFF);
    float mrun = -INFINITY, lsum = 0.f;
    const float ct = (MODE == 1) ? cs[t] : 0.f;
    KVRegs R;
    kv_load(R, Kh + (size_t)(ntiles - 1) * 64 * ldp, Vh + (size_t)(ntiles - 1) * 64 * ldp, ldp, tid);
    kv_store(R, lds, tid, 0);
    __syncthreads();
    for (int it = 0; it < ntiles; ++it) {
        const int jt = ntiles - 1 - it; const int kt0 = jt * 64; const int buf = it & 1;
        if (MODE == 0 && it > 0) { unsigned all = 1u;
#pragma unroll
            for (int w = 0; w < 8; ++w) all &= flg[(buf ^ 1) * 8 + w];
            if (all) break; }
        if (it + 1 < ntiles) kv_load(R, Kh + (size_t)(jt - 1) * 64 * ldp, Vh + (size_t)(jt - 1) * 64 * ldp, ldp, tid);
        const LAS unsigned char* kbase = lds + KS_OFF + buf * KBUF; const LAS unsigned char* vbase = lds + VT_OFF + buf * VBUF;
        if (kt0 > wtmax) { if (MODE == 0 && lane == 0) flg[buf * 8 + wid] = 0u; }
        else {
        f32x16 s0, s1;
        if (MODE == 0) {
#pragma unroll
            for (int i = 0; i < 16; ++i) { s0[i] = 0.f; s1[i] = 0.f; }
            qk_tile(s0, s1, qf, kbase, r32, hh);
            f32x16 L0, L1;
#pragma unroll
            for (int r = 0; r < 16; ++r) {
                { const float z = s0[r]; const float e = __builtin_amdgcn_exp2f(-fabsf(z)); const float rr = __builtin_amdgcn_rcpf(1.0f + e), er = e * rr; const bool pz = z >= 0.f; s0[r] = pz ? rr : er; L0[r] = pz ? er : rr; }
                { const float z = s1[r]; const float e = __builtin_amdgcn_exp2f(-fabsf(z)); const float rr = __builtin_amdgcn_rcpf(1.0f + e), er = e * rr; const bool pz = z >= 0.f; s1[r] = pz ? rr : er; L1[r] = pz ? er : rr; } }
            if (kt0 + 63 >= wtmin) {
#pragma unroll
                for (int r = 0; r < 16; ++r) { const int key = kt0 + crow(r, hh);
                    if (!(key < t)) { s0[r] = 0.f; L0[r] = 1.f; }
                    if (!(key + 32 < t)) { s1[r] = 0.f; L1[r] = 1.f; } }
            }
            float G0[4], G1[4], PG0[4], PG1[4], S0[4], S1[4];
#pragma unroll
            for (int g = 0; g < 4; ++g) { G0[g] = (L0[4 * g] * L0[4 * g + 1]) * (L0[4 * g + 2] * L0[4 * g + 3]); G1[g] = (L1[4 * g] * L1[4 * g + 1]) * (L1[4 * g + 2] * L1[4 * g + 3]); }
#pragma unroll
            for (int g = 0; g < 4; ++g) { PG0[g] = __shfl_xor(G0[g], 32); PG1[g] = __shfl_xor(G1[g], 32); }
            float run = carry;
#pragma unroll
            for (int g = 3; g >= 0; --g) { S1[g] = (hh == 0) ? run * PG1[g] : run; run *= G1[g] * PG1[g]; }
#pragma unroll
            for (int g = 3; g >= 0; --g) { S0[g] = (hh == 0) ? run * PG0[g] : run; run *= G0[g] * PG0[g]; }
            carry = run;
#pragma unroll
            for (int g = 0; g < 4; ++g) {
                float later0 = S0[g], later1 = S1[g];
#pragma unroll
                for (int e = 3; e >= 0; --e) { const int r = 4 * g + e;
                    s0[r] *= later0; later0 *= L0[r];
                    s1[r] *= later1; later1 *= L1[r]; }
            }
            { const bool wd = __all(carry == 0.f); if (lane == 0) flg[buf * 8 + wid] = wd ? 1u : 0u; }
        } else {
#pragma unroll
            for (int g = 0; g < 4; ++g) { const f32x4 c0 = *(const LAS f32x4*)(cs + kt0 + 8 * g + 4 * hh), c1 = *(const LAS f32x4*)(cs + kt0 + 32 + 8 * g + 4 * hh);
#pragma unroll
                for (int e = 0; e < 4; ++e) { s0[4 * g + e] = ct - c0[e]; s1[4 * g + e] = ct - c1[e]; } }
            qk_tile(s0, s1, qf, kbase, r32, hh);
            if (kt0 + 63 > wtmin) {
#pragma unroll
                for (int r = 0; r < 16; ++r) { const int key = kt0 + crow(r, hh);
                    if (key > t) s0[r] = -INFINITY;
                    if (key + 32 > t) s1[r] = -INFINITY; }
            }
            float mx = fmaxf(s0[0], s1[0]);
#pragma unroll
            for (int r = 1; r < 16; ++r) mx = fmaxf(fmaxf(mx, s0[r]), s1[r]);
            mx = fmaxf(mx, __shfl_xor(mx, 32));
            const float mnew = fmaxf(mrun, mx); const float muse = (mnew == -INFINITY) ? 0.f : mnew;
            const float alpha = __builtin_amdgcn_exp2f(mrun - muse);
            float ps = 0.f;
#pragma unroll
            for (int r = 0; r < 16; ++r) { s0[r] = __builtin_amdgcn_exp2f(s0[r] - muse); s1[r] = __builtin_amdgcn_exp2f(s1[r] - muse); ps += s0[r] + s1[r]; }
            lsum = lsum * alpha + ps; mrun = mnew;
            if (__any(alpha != 1.0f)) {
#pragma unroll
                for (int db = 0; db < 4; ++db)
#pragma unroll
                    for (int i = 0; i < 16; ++i) o[db][i] *= alpha; }
        }
        pv_tile(o, s0, s1, vbase, r32, hh);
        }
        if (it + 1 < ntiles) kv_store(R, lds, tid, buf ^ 1);
        __syncthreads();
    }
    float inv = 1.0f;
    if (MODE == 1) { const float lt = lsum + __shfl_xor(lsum, 32); inv = 1.0f / lt; }
    bf16* op = cat + (rowbase + t) * DM + catoff + h * 128;
#pragma unroll
    for (int db = 0; db < 4; ++db)
#pragma unroll
        for (int g = 0; g < 4; ++g) { u32x2 w; w.x = pk2(o[db][4 * g] * inv, o[db][4 * g + 1] * inv); w.y = pk2(o[db][4 * g + 2] * inv, o[db][4 * g + 3] * inv);
            *(u32x2*)(op + db * 32 + 8 * g + 4 * hh) = w; }
}

__device__ __forceinline__ void shortconv_phase(const bf16* __restrict__ P, const float* __restrict__ w, bf16* __restrict__ cat, size_t gt, size_t gs) {
    for (size_t i = gt; i < (size_t)(M / 8) * 128; i += gs) {
        const int cg8 = (int)(i & 127), m0 = (int)(i >> 7) * 8, tpos0 = m0 & (SEQ - 1), c0 = cg8 * 8;
        float w0[8], w1[8], w2[8];
        { const f32x4 a = *(const f32x4*)(w + c0), b = *(const f32x4*)(w + c0 + 4), c = *(const f32x4*)(w + 1024 + c0), d = *(const f32x4*)(w + 1024 + c0 + 4), e = *(const f32x4*)(w + 2048 + c0), f = *(const f32x4*)(w + 2048 + c0 + 4);
#pragma unroll
          for (int k = 0; k < 4; ++k) { w0[k] = a[k]; w0[4 + k] = b[k]; w1[k] = c[k]; w1[4 + k] = d[k]; w2[k] = e[k]; w2[4 + k] = f[k]; } }
        float p2[8], p1[8];
#pragma unroll
        for (int e = 0; e < 8; ++e) { p2[e] = 0.f; p1[e] = 0.f; }
        if (tpos0 >= 2) {
            const bf16* r2 = P + (size_t)(m0 - 2) * NIN0; const bf16* r1 = r2 + NIN0;
            const u32x4 gc2 = *(const u32x4*)(r2 + 4096 + c0), hn2 = *(const u32x4*)(r2 + 5120 + c0), gc1 = *(const u32x4*)(r1 + 4096 + c0), hn1 = *(const u32x4*)(r1 + 5120 + c0);
#pragma unroll
            for (int e = 0; e < 4; ++e) { p2[2 * e] = bflo(gc2[e]) * bflo(hn2[e]); p2[2 * e + 1] = bfhi(gc2[e]) * bfhi(hn2[e]); p1[2 * e] = bflo(gc1[e]) * bflo(hn1[e]); p1[2 * e + 1] = bfhi(gc1[e]) * bfhi(hn1[e]); }
        }
#pragma unroll
        for (int j = 0; j < 8; ++j) {
            const bf16* row = P + (size_t)(m0 + j) * NIN0;
            const u32x4 gb = *(const u32x4*)(row + 3072 + c0), gc = *(const u32x4*)(row + 4096 + c0), hn = *(const u32x4*)(row + 5120 + c0);
            float p0[8];
#pragma unroll
            for (int e = 0; e < 4; ++e) { p0[2 * e] = bflo(gc[e]) * bflo(hn[e]); p0[2 * e + 1] = bfhi(gc[e]) * bfhi(hn[e]); }
            u32x4 ow;
#pragma unroll
            for (int e = 0; e < 4; ++e) { const float y0 = w0[2 * e] * p2[2 * e] + w1[2 * e] * p1[2 * e] + w2[2 * e] * p0[2 * e], y1 = w0[2 * e + 1] * p2[2 * e + 1] + w1[2 * e + 1] * p1[2 * e + 1] + w2[2 * e + 1] * p0[2 * e + 1];
                ow[e] = pk2(bflo(gb[e]) * y0, bfhi(gb[e]) * y1); }
            *(u32x4*)(cat + (size_t)(m0 + j) * DM + 1024 + c0) = ow;
#pragma unroll
            for (int e = 0; e < 8; ++e) { p2[e] = p1[e]; p1[e] = p0[e]; }
        }
    }
}

__device__ __forceinline__ float wave_sum8(const float (&a8)[8], int lane) {
    const bool b2 = (lane & 4) != 0, b1 = (lane & 2) != 0, b0 = (lane & 1) != 0;
    float bq[4], cq[2], r;
#pragma unroll
    for (int i = 0; i < 4; ++i) { const float snd = b2 ? a8[i] : a8[i + 4]; const float rcv = __shfl_xor(snd, 4); bq[i] = (b2 ? a8[i + 4] : a8[i]) + rcv; }
#pragma unroll
    for (int i = 0; i < 2; ++i) { const float snd = b1 ? bq[i] : bq[i + 2]; const float rcv = __shfl_xor(snd, 2); cq[i] = (b1 ? bq[i + 2] : bq[i]) + rcv; }
    { const float snd = b0 ? cq[0] : cq[1]; const float rcv = __shfl_xor(snd, 1); r = (b0 ? cq[1] : cq[0]) + rcv; }
    r += __shfl_xor(r, 8); r += __shfl_xor(r, 16); r += __shfl_xor(r, 32);
    return r;
}
__device__ __forceinline__ void gmlp_stats(LAS unsigned char* lds, const bf16* __restrict__ P, int b, int n) {
    const int tid = opaque_tid(), lane = tid & 63, wid = __builtin_amdgcn_readfirstlane(tid >> 6);
    const size_t row0 = (size_t)b * SEQ + (size_t)n * 128;
    LAS float* stat = (LAS float*)lds;
    __syncthreads();
#pragma unroll 1
    for (int hb = 0; hb < 2; ++hb) {
        u32x4 av[8], cv[8];
#pragma unroll
        for (int i = 0; i < 8; ++i) { const bf16* vp = P + (row0 + wid * 16 + hb * 8 + i) * NIN1 + 1024 + lane * 16; av[i] = *(const u32x4*)vp; cv[i] = *(const u32x4*)(vp + 8); }
        float s1[8], s2[8];
#pragma unroll
        for (int i = 0; i < 8; ++i) { float a = 0.f, q = 0.f;
#pragma unroll
            for (int e = 0; e < 4; ++e) { const float x0 = bflo(av[i][e]), x1 = bfhi(av[i][e]), x2 = bflo(cv[i][e]), x3 = bfhi(cv[i][e]); a += (x0 + x1) + (x2 + x3); q += (x0 * x0 + x1 * x1) + (x2 * x2 + x3 * x3); }
            s1[i] = a; s2[i] = q; }
        const float t1 = wave_sum8(s1, lane), t2 = wave_sum8(s2, lane);
        const float mean = t1 * (1.0f / 1024.0f);
        const float var = fmaxf(t2 * (1.0f / 1024.0f) - mean * mean, 0.f);
        if (lane < 8) { const int tk = wid * 16 + hb * 8 + lane; stat[2 * tk] = mean; stat[2 * tk + 1] = 1.0f / sqrtf(var + EPS); }
    }
    __syncthreads();
}
__device__ __forceinline__ void gmlp_item(LAS unsigned char* lds, const bf16* __restrict__ P, const float* __restrict__ sgw, const float* __restrict__ sgb, const float* __restrict__ gn,
                                          bf16* __restrict__ cat, int b, int n, int g) {
    const int tid = opaque_tid(), lane = tid & 63, wid = __builtin_amdgcn_readfirstlane(tid >> 6), r32 = lane & 31, hh = lane >> 5;
    const size_t row0 = (size_t)b * SEQ + (size_t)n * 128;
    LAS float* stat = (LAS float*)lds;
    LAS unsigned char* vnT = lds + 1024;
    LAS unsigned char* Wl = lds + 1024 + 128 * 272;
    __syncthreads();
    f32x4 wa[4], wc[4]; u32x4 va[2], vc[2];
#pragma unroll
    for (int i = 0; i < 4; ++i) { const int task = tid + 512 * i, tt = task >> 4, s8 = (task & 15) * 8; const float* wp = sgw + ((size_t)g * 128 + tt) * 128 + s8; wa[i] = *(const f32x4*)wp; wc[i] = *(const f32x4*)(wp + 4); }
#pragma unroll
    for (int i = 0; i < 2; ++i) { const int task = tid + 512 * i, sp = task & 63, c8 = task >> 6; const bf16* vp = P + (row0 + 2 * sp) * NIN1 + 1024 + g * 128 + c8 * 8; va[i] = *(const u32x4*)vp; vc[i] = *(const u32x4*)(vp + NIN1); }
#pragma unroll
    for (int i = 0; i < 2; ++i) { const int task = tid + 512 * i, sp = task & 63, c8 = task >> 6;
        const u32x4 a = va[i], c = vc[i];
        const float m0 = stat[4 * sp], r0 = stat[4 * sp + 1], m1 = stat[4 * sp + 2], r1 = stat[4 * sp + 3];
        const f32x4 g0 = *(const f32x4*)(gn + g * 128 + c8 * 8), g1 = *(const f32x4*)(gn + g * 128 + c8 * 8 + 4);
#pragma unroll
        for (int e = 0; e < 8; ++e) { const float gg = (e < 4) ? g0[e & 3] : g1[e & 3];
            const float x0 = (e & 1) ? bfhi(a[e >> 1]) : bflo(a[e >> 1]), x1 = (e & 1) ? bfhi(c[e >> 1]) : bflo(c[e >> 1]);
            *(LAS unsigned*)(vnT + (c8 * 8 + e) * 272 + sp * 4) = pk2((x0 - m0) * r0 * gg, (x1 - m1) * r1 * gg); } }
#pragma unroll
    for (int i = 0; i < 4; ++i) { const int task = tid + 512 * i, tt = task >> 4, s8 = (task & 15) * 8;
        float x[8] = {wa[i].x, wa[i].y, wa[i].z, wa[i].w, wc[i].x, wc[i].y, wc[i].z, wc[i].w};
#pragma unroll
        for (int e = 0; e < 8; ++e) if (s8 + e > tt) x[e] = 0.f;
        u32x4 w; w.x = pk2(x[0], x[1]); w.y = pk2(x[2], x[3]); w.z = pk2(x[4], x[5]); w.w = pk2(x[6], x[7]);
        *(LAS u32x4*)(Wl + tt * 272 + s8 * 2) = w; }
    __syncthreads();
    const int tb = wid & 3, chf = wid >> 2;
    f32x16 acc[2];
#pragma unroll
    for (int cb = 0; cb < 2; ++cb)
#pragma unroll
        for (int i = 0; i < 16; ++i) acc[cb][i] = 0.f;
#pragma unroll
    for (int s0 = 0; s0 < 8; ++s0) {
        const bf16x8 a = *(const LAS bf16x8*)(Wl + (32 * tb + r32) * 272 + s0 * 32 + hh * 16);
#pragma unroll
        for (int cb = 0; cb < 2; ++cb) { const bf16x8 bb = *(const LAS bf16x8*)(vnT + (64 * chf + 32 * cb + r32) * 272 + s0 * 32 + hh * 16); acc[cb] = MFMA32(a, bb, acc[cb]); }
    }
    LAS float* ot = (LAS float*)(lds + 1024 + 2 * 128 * 272);
#pragma unroll
    for (int cb = 0; cb < 2; ++cb)
#pragma unroll
        for (int r = 0; r < 16; ++r) ot[(32 * tb + crow(r, hh)) * 132 + 64 * chf + 32 * cb + r32] = acc[cb][r];
    __syncthreads();
#pragma unroll
    for (int i = 0; i < 4; ++i) { const int task = tid + 512 * i, tt = task >> 4, c8 = (task & 15) * 8;
        const u32x4 uv = *(const u32x4*)(P + (row0 + tt) * NIN1 + g * 128 + c8);
        const f32x4 m0 = *(const LAS f32x4*)(ot + tt * 132 + c8), m1 = *(const LAS f32x4*)(ot + tt * 132 + c8 + 4);
        const float bs = sgb[g * 128 + tt];
        u32x4 ow;
        ow.x = pk2(bflo(uv.x) * (m0[0] + bs), bfhi(uv.x) * (m0[1] + bs)); ow.y = pk2(bflo(uv.y) * (m0[2] + bs), bfhi(uv.y) * (m0[3] + bs));
        ow.z = pk2(bflo(uv.z) * (m1[0] + bs), bfhi(uv.z) * (m1[1] + bs)); ow.w = pk2(bflo(uv.w) * (m1[2] + bs), bfhi(uv.w) * (m1[3] + bs));
        *(u32x4*)(cat + (row0 + tt) * DM + g * 128 + c8) = ow; }
}

__device__ __forceinline__ void fixup_tile(const float* __restrict__ side, const float* __restrict__ cw, bf16* __restrict__ act, int pm, int tid) {
    for (int idx = tid; idx < 2 * (DFF / 4); idx += 512) {
        const int j = idx / (DFF / 4), ch = (idx % (DFF / 4)) * 4;
        const int colg = (ch >> 7) * 256 + (ch & 127), colu = colg + 128;
        f32x4 yg = *(const f32x4*)(side + (size_t)(pm * 4 + j) * NUP + colg), yu = *(const f32x4*)(side + (size_t)(pm * 4 + j) * NUP + colu);
        if (pm & 7) {
            const f32x4 g255 = *(const f32x4*)(side + (size_t)((pm - 1) * 4 + 3) * NUP + colg), g254 = *(const f32x4*)(side + (size_t)((pm - 1) * 4 + 2) * NUP + colg);
            const f32x4 u255 = *(const f32x4*)(side + (size_t)((pm - 1) * 4 + 3) * NUP + colu), u254 = *(const f32x4*)(side + (size_t)((pm - 1) * 4 + 2) * NUP + colu);
            const f32x4 wg0 = *(const f32x4*)(cw + ch), wg1 = *(const f32x4*)(cw + NUP + ch), wu0 = *(const f32x4*)(cw + DFF + ch), wu1 = *(const f32x4*)(cw + NUP + DFF + ch);
            if (j == 0) { yg += wg1 * g255 + wg0 * g254; yu += wu1 * u255 + wu0 * u254; } else { yg += wg0 * g255; yu += wu0 * u255; }
        }
        u32x2 w; w.x = pk2(pg8::silu_f(yg[0]) * yu[0], pg8::silu_f(yg[1]) * yu[1]); w.y = pk2(pg8::silu_f(yg[2]) * yu[2], pg8::silu_f(yg[3]) * yu[3]);
        *(u32x2*)(act + (size_t)(pm * 256 + j) * DFF + ch) = w;
    }
}

__global__ void __launch_bounds__(512, 2) fwd(Params P) {
    extern __shared__ __attribute__((aligned(16))) unsigned char lds_raw[];
    LAS unsigned char* lds = (LAS unsigned char*)lds_raw;
    cg::grid_group grid = cg::this_grid();
    const int G = gridDim.x, bx = blockIdx.x;
#define PH_IDX const int tid = opaque_tid(), lane = tid & 63, wave = __builtin_amdgcn_readfirstlane(tid >> 6); const int gw = bx * 8 + wave, ngw = G * 8; const size_t gt = (size_t)bx * 512 + tid, gs = (size_t)G * 512; (void)lane; (void)gw; (void)ngw; (void)gt; (void)gs;
    unsigned char* ws = P.ws;
    float* flog = (float*)(ws + WS_FLOG); float* side = (float*)(ws + WS_SIDE);
#define Wt_in(l) ((bf16*)(ws + ((l) == 0 ? WS_WIN0 : WS_WIN1)))
#define Wt_out(l) ((bf16*)(ws + ((l) == 0 ? WS_WOUT0 : WS_WOUT1)))
#define Wt_up(l) ((bf16*)(ws + ((l) == 0 ? WS_WUP0 : WS_WUP1)))
#define Wt_dn(l) ((bf16*)(ws + ((l) == 0 ? WS_WDN0 : WS_WDN1)))
    bf16* Hb = (bf16*)(ws + WS_H); bf16* Pb = (bf16*)(ws + WS_P); bf16* Hb2 = (bf16*)(ws + WS_HB2); float* ssq = (float*)(ws + WS_SSQ);
    float* X = P.out;
    LAS float* hal = (LAS float*)(lds + HAL_OFF);
    if (threadIdx.x < 8) ((volatile LAS unsigned*)(lds + MISC_OFF))[threadIdx.x] = 0u;
    __syncthreads();
    if (blockIdx.x == 0) { for (int i = threadIdx.x; i < XCD_BAR_WORDS; i += 512) __hip_atomic_store((unsigned*)ws + i, 0u, __ATOMIC_RELAXED, __HIP_MEMORY_SCOPE_AGENT); }

    {
        PH_IDX
        LAS float* scr = (LAS float*)(lds + wave * 16384);
        constexpr int I_IN0 = 32 * 192, I_OUT = 32 * 64, I_UP = 32 * 352, I_DN = 88 * 64, I_IN1 = 32 * 160;
        constexpr int NITEMS = I_IN0 + I_IN1 + 2 * (I_OUT + I_UP + I_DN);
#ifndef SKIP_TR
        for (int it = gw; it < NITEMS; it += ngw) {
            int r = it;
            if (r < I_IN0) { transpose_item<0>(P.in[2], DM, NIN0, 192, Wt_in(0), scr, r, lane); continue; } r -= I_IN0;
            if (r < I_IN1) { transpose_item<0>(P.in[10], DM, LDW1, 160, Wt_in(1), scr, r, lane); continue; } r -= I_IN1;
            if (r < I_OUT) { transpose_item<0>(P.in[4], DM, DM, 64, Wt_out(0), scr, r, lane); continue; } r -= I_OUT;
            if (r < I_OUT) { transpose_item<0>(P.in[15], DM, DM, 64, Wt_out(1), scr, r, lane); continue; } r -= I_OUT;
            if (r < I_UP) { transpose_item<1>(P.in[6], DM, NUP, 352, Wt_up(0), scr, r, lane, P.in[5]); continue; } r -= I_UP;
            if (r < I_UP) { transpose_item<1>(P.in[17], DM, NUP, 352, Wt_up(1), scr, r, lane, P.in[16]); continue; } r -= I_UP;
            if (r < I_DN) { transpose_item<0>(P.in[8], DFF, DM, 64, Wt_dn(0), scr, r, lane); continue; } r -= I_DN;
            transpose_item<0>(P.in[19], DFF, DM, 64, Wt_dn(1), scr, r, lane);
        }
#endif
        rms_rows<0>(P.in[0], P.in[1], Hb, nullptr, nullptr, nullptr, gw, ngw, lane);
    }
    grid.sync();
#ifdef USE_CG_SYNC
#define GSYNC() grid.sync()
#elif defined(USE_CTR_SYNC)
    unsigned bar_round = 0;
#define GSYNC() do { ++bar_round; ctr_barrier((unsigned*)ws + 64, bar_round * (unsigned)G); } while (0)
#else
#ifdef XB_FENCE_ALL
#define GSYNC() xcd_barrier(xbar)
#else
#define GSYNC() xcd_barrier(xbar)
#endif
#endif
    const XcdBarrier xbar = xcd_barrier_post((unsigned*)ws, (volatile LAS unsigned*)(lds + MISC_OFF));

    for (int layer = 0; layer < 2; ++layer) {
        {
            const int N = layer == 0 ? NIN0 : NIN1;
            pg8::Gemm g{Hb, Wt_in(layer), M, N, DM}; pg8::StaticOrder S; S.init(M, N, G, bx);
            pg8::EpiStore E{Pb, N, layer == 0 ? 0 : 8};
#ifndef SKIP_IN
            pg8::gemm_phase<pg8::EpiStore, pg8::StaticOrder, true, true>(lds, g, S, E);
#endif
        }
        GSYNC();
#ifdef PROBE_SYNC
        for (int i = 0; i < 10; ++i) GSYNC();
#endif
#ifdef PROBE_MIX
        for (int rep = 0; rep < 2; ++rep)
#endif
        if (layer == 0) {
            PH_IDX
            for (int pi = bx; pi < 256; pi += G) { const int bh = pi >> 2, s = pi & 3;
#ifndef SKIP_ATT0
                attn_item<0>(lds, Pb, NIN0, 0, 1024, 2048, Hb, 0, bh >> 3, bh & 7, 7 - s, nullptr, 0.f);
                attn_item<0>(lds, Pb, NIN0, 0, 1024, 2048, Hb, 0, bh >> 3, bh & 7, s, nullptr, 0.f);
#endif
            }
#ifndef SKIP_SC
            shortconv_phase(Pb, P.in[3], Hb, gt, gs);
#endif
        } else {
            for (int pi = bx; pi < 256; pi += G) { const int bh = pi >> 2, s = pi & 3; const float bfh = P.in[11][bh & 7];
#ifndef SKIP_ATT1
                attn_item<1>(lds, Pb, NIN1, 2048, 3072, 4096, Hb, 1024, bh >> 3, bh & 7, 7 - s, flog, bfh);
                attn_item<1>(lds, Pb, NIN1, 2048, 3072, 4096, Hb, 1024, bh >> 3, bh & 7, s, flog, bfh);
#endif
            }
#ifndef SKIP_GMLP
            for (int pr = bx; pr < 256; pr += G) { const int bn = pr >> 1, gh = pr & 1;
                gmlp_stats(lds, Pb, bn >> 4, bn & 15);
                for (int g4 = 0; g4 < 4; ++g4) gmlp_item(lds, Pb, P.in[12], P.in[13], P.in[14], Hb, bn >> 4, bn & 15, 4 * gh + g4); }
#endif
        }
        GSYNC();
        {
            pg8::Gemm g{Hb, Wt_out(layer), M, DM, DM}; pg8::StaticOrder S; S.init(M, DM, G, bx);
            if (layer == 0) { pg8::EpiResidT<true, false> E{P.in[0], X, DM, Hb2, ssq, nullptr};
                pg8::gemm_phase<pg8::EpiResidT<true, false>, pg8::StaticOrder, true, true>(lds, g, S, E); }
            else { pg8::EpiResidT<true, false, true> E{nullptr, X, DM, Hb2, ssq, Hb2};
                pg8::gemm_phase<pg8::EpiResidT<true, false, true>, pg8::StaticOrder, true, true>(lds, g, S, E); }
        }
        GSYNC();
#ifdef PROBE_UP
        for (int rep = 0; rep < 2; ++rep)
#endif
        {
            pg8::Gemm g{Hb2, Wt_up(layer), M, NUP, DM}; pg8::StaticOrder S; S.init(M, NUP, G, bx);
            LAS float* rsl = (LAS float*)(lds + MISC_OFF + 64);
            pg8::Unit u0; int pm0 = -1;
            if (S.next(0, u0)) { pm0 = u0.pm;
                PH_IDX
                if (tid < 256) { const float* sp = ssq + (size_t)(pm0 * 256 + tid) * 32; float t = 0.f;
#pragma unroll
                    for (int j = 0; j < 8; ++j) { const f32x4 a = *(const f32x4*)(sp + 4 * j); t += (a[0] + a[1]) + (a[2] + a[3]); }
                    rsl[tid] = 1.0f / sqrtf(t * (1.0f / 2048.0f) + 1e-6f); }
                __syncthreads(); }
            pg8::EpiUpConv E{Pb, (layer == 0 ? P.in[7] : P.in[18]), side, hal, ssq, rsl, (LAS float*)(lds + MISC_OFF + 1152), pm0};
#ifndef SKIP_UP
            pg8::gemm_phase<pg8::EpiUpConv, pg8::StaticOrder, true, true>(lds, g, S, E);
#endif
        }
        GSYNC();
        {
            pg8::Gemm g{Pb, Wt_dn(layer), M, DM, DFF}; pg8::StaticOrder S; S.init(M, DM, G, bx);
            {
                PH_IDX pg8::Unit fu;
                for (int i = 0; S.next(i, fu); ++i) fixup_tile(side, (layer == 0 ? P.in[7] : P.in[18]), Pb, fu.pm, tid);
                asm volatile("s_waitcnt vmcnt(0)" ::: "memory"); __syncthreads();
            }
            pg8::EpiResidT<true, false, true> E{nullptr, X, DM, Hb2, ssq, Hb2};
            pg8::gemm_phase<pg8::EpiResidT<true, false, true>, pg8::StaticOrder, true, true>(lds, g, S, E);
        }
        GSYNC();
        if (layer == 0) {
            PH_IDX
            LAS float* WfT = (LAS float*)lds;
            for (int idx = tid; idx < DM * 8; idx += 512) { const int k = idx >> 3, j = idx & 7; WfT[j * DM + k] = P.in[10][(size_t)k * LDW1 + NIN1 + j]; }
            __syncthreads();
#ifndef SKIP_RMS1
            rms1_rows_bf16(Hb2, ssq, P.in[9], Hb, WfT, flog, gw, ngw, lane);
#endif
            __syncthreads();
            GSYNC();
        }
    }
    {
        PH_IDX
        const float* gf = P.in[20];
        f32x4 gv[8];
#pragma unroll
        for (int j = 0; j < 8; ++j) gv[j] = ((const f32x4*)gf)[64 * j + lane];
        for (int m = gw; m < M; m += ngw) {
            const float part = (lane < 32) ? ssq[(size_t)m * 32 + lane] : 0.f;
            const float rs = 1.0f / sqrtf(wave_sum(part) * (1.0f / DM) + EPS);
            const u32x2* xr = (const u32x2*)(Hb2 + (size_t)m * DM) + lane;
            f32x4* o = (f32x4*)(X + (size_t)m * DM) + lane;
            u32x2 xv[8];
#pragma unroll
            for (int j = 0; j < 8; ++j) xv[j] = xr[64 * j];
#pragma unroll
            for (int j = 0; j < 8; ++j) { f32x4 v; v.x = bflo(xv[j].x); v.y = bfhi(xv[j].x); v.z = bflo(xv[j].y); v.w = bfhi(xv[j].y); o[64 * j] = v * rs * gv[j]; }
        }
    }
}

extern "C" void kernel_launch(void* const* d_in, const int* in_sizes, int n_in, void* d_out, int out_size, void* d_ws, size_t ws_size, hipStream_t stream) {
    static int grid = 0;
    if (grid == 0) {
        int dev = 0, cus = 0, per_cu = 0;
        (void)hipGetDevice(&dev);
        (void)hipDeviceGetAttribute(&cus, hipDeviceAttributeMultiprocessorCount, dev);
        (void)hipFuncSetAttribute((const void*)fwd, hipFuncAttributeMaxDynamicSharedMemorySize, LDS_BYTES);
        (void)hipOccupancyMaxActiveBlocksPerMultiprocessor(&per_cu, (const void*)fwd, 512, LDS_BYTES);
        (void)hipGetLastError();
        if (cus <= 0) cus = 256;
        grid = cus;
        if (n_in != 21 || ws_size < WS_END) fprintf(stderr, "kernel_launch: unexpected n_in %d / ws %zu\n", n_in, ws_size);
    }
    Params p{};
    for (int i = 0; i < 21 && i < n_in; ++i) p.in[i] = (const float*)d_in[i];
    p.out = (float*)d_out; p.ws = (unsigned char*)d_ws;
    void* args[] = {&p};
    hipError_t e = hipLaunchCooperativeKernel((const void*)fwd, dim3(grid), dim3(512), args, LDS_BYTES, stream);
    if (e != hipSuccess) fprintf(stderr, "cooperative launch failed: %s (grid %d)\n", hipGetErrorString(e), grid);
}
```

```cpp
#include <hip/hip_runtime.h>
#include <hip/hip_cooperative_groups.h>
#include <cstdio>
#include <cstdint>
namespace cg = cooperative_groups;
__device__ __forceinline__ int opaque_tid() { int t = threadIdx.x; asm volatile("" : "+v"(t)); return t; }

namespace pg8 {
#define PG8_LAS __attribute__((address_space(3)))
typedef unsigned short bf16_t;
typedef short bf16x8 __attribute__((ext_vector_type(8)));
typedef float f32x4 __attribute__((ext_vector_type(4)));
typedef float f32x2 __attribute__((ext_vector_type(2)));
typedef unsigned u32x4 __attribute__((ext_vector_type(4)));
typedef unsigned u32x2 __attribute__((ext_vector_type(2)));
constexpr int BM = 256, BK = 64, HALF = 128, HTB = HALF * BK * 2, STAGE_BYTES = 8 * HTB, NXCD = 8, WGM = 8;

__host__ __device__ __forceinline__ int lds_byte(int r, int c) { const int st = (r >> 4) * 2 + (c >> 5), rr = r & 15, cc = c & 31, ob = rr * 64 + cc * 2; return st * 1024 + (ob ^ (((ob >> 9) & 1) << 5)); }
__host__ __device__ __forceinline__ void stage_rc(int b, int& R, int& C) { const int st = b / 1024, sb = b % 1024, swz = sb ^ (((sb >> 9) & 1) << 5); R = (st >> 1) * 16 + swz / 64; C = (st & 1) * 32 + (swz % 64) / 2; }
__host__ __device__ __forceinline__ int perm32(int rho) { const int n = rho >> 4, i = rho & 15; return 8 * (i >> 2) + 4 * n + (i & 3); }

struct Unit { int pm, pn; };
struct Gemm { const bf16_t* A; const bf16_t* Bt; int M, N, K; };

struct StaticOrder {
    int nM, nN, nwg, G, c;
    __host__ __device__ void init(int M, int N, int G_, int c_) { nM = M / BM; nN = N / BM; nwg = nM * nN; G = G_; c = c_; }
    __host__ __device__ bool next(int i, Unit& u) const {
        const long L = (long)i * G + c; if (L >= nwg) return false;
        int wgid = (int)L; { const int q = nwg / NXCD, r = nwg % NXCD, xcd = wgid % NXCD, off = wgid / NXCD; wgid = (xcd < r ? xcd * (q + 1) : r * (q + 1) + (xcd - r) * q) + off; }
        const int nig = WGM * nN, gid = wgid / nig, fm = gid * WGM, gsz = (nM - fm) < WGM ? (nM - fm) : WGM;
        u.pm = fm + ((wgid % nig) % gsz); u.pn = (wgid % nig) / gsz; return true;
    }
    __device__ __forceinline__ void a_ready(const Unit&) const {}
    __device__ __forceinline__ void done(const Unit&) const {}
};

__device__ __forceinline__ unsigned cvt_pk_bf16(float lo, float hi) { unsigned r; asm volatile("v_cvt_pk_bf16_f32 %0, %1, %2" : "=v"(r) : "v"(lo), "v"(hi)); return r; }
__device__ __forceinline__ float gelu_tanh(float x) { const float u2 = 1.5957691216057308f * (x + 0.044715f * x * x * x); return x * __builtin_amdgcn_rcpf(1.0f + __expf(-u2)); }
__device__ __forceinline__ float silu_f(float x) { return x * __builtin_amdgcn_rcpf(1.0f + __expf(-x)); }

struct EpiStore {
    static constexpr bool PERM = true, AFTER_DRAIN = false, INIT = false, HOOK = false, PERMA = false;
    bf16_t* O; int ldc; int gelu_tiles;
    __device__ __forceinline__ void operator()(const f32x4 (&acc)[2][2][4][2], const Unit& u, int wr, int wc, int fr, int fq) const {
        const int row0 = u.pm * BM + wr * 64 + fr; const int col0 = u.pn * BM + wc * 32 + 8 * fq;
        const bool g = u.pn < gelu_tiles;
#pragma unroll
        for (int ai = 0; ai < 2; ++ai)
#pragma unroll
            for (int m = 0; m < 4; ++m) { bf16_t* rowp = O + (size_t)(row0 + ai * HALF + m * 16) * ldc + col0;
#pragma unroll
                for (int bj = 0; bj < 2; ++bj) { f32x4 v0 = acc[ai][bj][m][0], v1 = acc[ai][bj][m][1];
                    if (g) {
#pragma unroll
                        for (int e = 0; e < 4; ++e) { v0[e] = gelu_tanh(v0[e]); v1[e] = gelu_tanh(v1[e]); } }
                    u32x4 w; w.x = cvt_pk_bf16(v0[0], v0[1]); w.y = cvt_pk_bf16(v0[2], v0[3]); w.z = cvt_pk_bf16(v1[0], v1[1]); w.w = cvt_pk_bf16(v1[2], v1[3]);
                    *(u32x4*)(rowp + bj * HALF) = w; }
                if (m & 1) asm volatile("" ::: "memory"); }
    }
};
template <bool NOUT, bool WF32 = true, bool RB16 = false> struct EpiResidT {
    static constexpr bool PERM = false, AFTER_DRAIN = false, INIT = true, HOOK = false, PERMA = false;
    const float* base; float* out; int ldc; bf16_t* xb; float* ssq; const bf16_t* xb16;
    __device__ __forceinline__ void init(f32x4 (&acc)[2][2][4][2], const Unit& u, int wr, int wc, int fr, int fq) const {
        const int col0 = u.pn * BM + wc * 32 + 4 * fq;
#pragma unroll
        for (int ai = 0; ai < 2; ++ai)
#pragma unroll
            for (int m = 0; m < 4; ++m) { const size_t off = (size_t)(u.pm * BM + ai * HALF + wr * 64 + m * 16 + fr) * ldc + col0;
#pragma unroll
                for (int bj = 0; bj < 2; ++bj)
#pragma unroll
                    for (int n = 0; n < 2; ++n) {
                        if (RB16) { const u32x2 w = *(const u32x2*)(xb16 + off + bj * HALF + n * 16); acc[ai][bj][m][n] = (f32x4){__uint_as_float(w.x << 16), __uint_as_float(w.x & 0xffff0000u), __uint_as_float(w.y << 16), __uint_as_float(w.y & 0xffff0000u)}; }
                        else acc[ai][bj][m][n] = *(const f32x4*)(base + off + bj * HALF + n * 16); } }
    }
    __device__ __forceinline__ void operator()(const f32x4 (&acc)[2][2][4][2], const Unit& u, int wr, int wc, int fr, int fq) const {
        const int col0 = u.pn * BM + wc * 32 + 4 * fq;
#pragma unroll
        for (int ai = 0; ai < 2; ++ai)
#pragma unroll
            for (int m = 0; m < 4; ++m) { const int row = u.pm * BM + ai * HALF + wr * 64 + m * 16 + fr; const size_t off = (size_t)row * ldc + col0;
                float sq = 0.f;
#pragma unroll
                for (int bj = 0; bj < 2; ++bj)
#pragma unroll
                    for (int n = 0; n < 2; ++n) { const f32x4 o = acc[ai][bj][m][n]; if (WF32) *(f32x4*)(out + off + bj * HALF + n * 16) = o;
                        if (NOUT) { u32x2 w; w.x = cvt_pk_bf16(o[0], o[1]); w.y = cvt_pk_bf16(o[2], o[3]); *(u32x2*)(xb + off + bj * HALF + n * 16) = w; sq += (o[0] * o[0] + o[1] * o[1]) + (o[2] * o[2] + o[3] * o[3]); } }
                if (NOUT) { sq += __shfl_xor(sq, 16); sq += __shfl_xor(sq, 32); if (fq == 0) ssq[(size_t)row * 32 + u.pn * 4 + wc] = sq; }
                asm volatile("" ::: "memory"); }
    }
};
constexpr int NUPC = 11264, DFFC = 5632;
struct EpiUpConv {
    static constexpr bool PERM = true, AFTER_DRAIN = false, INIT = false, HOOK = true, PERMA = true;
    bf16_t* act; const float* cw; float* side; PG8_LAS float* hal; const float* ssq; PG8_LAS float* rs; PG8_LAS float* cwl2; int pm0;
    __device__ __forceinline__ void begin_unit(const Unit& u, int ui, int wid, int lane) const {
        if (wid < 3) { const float* src = cw + wid * NUPC + (lane >> 5) * DFFC + u.pn * HALF + (lane & 31) * 4;
            __builtin_amdgcn_global_load_lds((const unsigned*)src, (PG8_LAS unsigned*)(cwl2 + (ui & 1) * 768 + wid * 256), 16, 0, 0); }
    }
    __device__ __forceinline__ void operator()(f32x4 (&acc)[2][2][4][2], const Unit& u, int wr, int wc, int fr, int fq, int ui) const {
        const PG8_LAS float* cwl = cwl2 + (ui & 1) * 768;
        if (u.pm != pm0) {
            int l2 = fq * 16 + fr; asm volatile("" : "+v"(l2));
            const int rl = (wr * 4 + wc) * 32 + (l2 & 31), hf = l2 >> 5;
            const float* sp = ssq + (size_t)(u.pm * BM + rl) * 32 + hf * 16;
            const f32x4 a0 = *(const f32x4*)sp, a1 = *(const f32x4*)(sp + 4), a2 = *(const f32x4*)(sp + 8), a3 = *(const f32x4*)(sp + 12);
            float t = ((a0[0] + a0[1]) + (a0[2] + a0[3])) + ((a1[0] + a1[1]) + (a1[2] + a1[3])) + ((a2[0] + a2[1]) + (a2[2] + a2[3])) + ((a3[0] + a3[1]) + (a3[2] + a3[3]));
            t += __shfl_xor(t, 32);
            asm volatile("s_waitcnt lgkmcnt(0)" ::: "memory"); __builtin_amdgcn_s_barrier(); asm volatile("" ::: "memory");
            if (hf == 0) rs[rl] = 1.0f / sqrtf(t * (1.0f / 2048.0f) + 1e-6f);
            asm volatile("s_waitcnt lgkmcnt(0)" ::: "memory"); __builtin_amdgcn_s_barrier(); asm volatile("" ::: "memory");
        }
        {
            int frr = fr; asm volatile("" : "+v"(frr));
            const PG8_LAS float* rp = rs + wr * 64 + 4 * frr;
#pragma unroll
            for (int ai = 0; ai < 2; ++ai)
#pragma unroll
                for (int m = 0; m < 4; ++m) { const float r = rp[ai * HALF + m];
#pragma unroll
                    for (int bj = 0; bj < 2; ++bj)
#pragma unroll
                        for (int n = 0; n < 2; ++n) acc[ai][bj][m][n] = acc[ai][bj][m][n] * r; }
        }
        int cl = wc * 32 + 8 * fq; asm volatile("" : "+v"(cl));
        const PG8_LAS unsigned char* halr = (const PG8_LAS unsigned char*)hal - 2048 + wr * 2048 + cl * 4;
        if (fr == 15) {
            PG8_LAS unsigned char* halw = (PG8_LAS unsigned char*)hal + wr * 2048 + cl * 4;
#pragma unroll
            for (int ai = 0; ai < 2; ++ai) { const int s = 2 * ai + wr;
#pragma unroll
                for (int j = 0; j < 2; ++j)
#pragma unroll
                    for (int bj = 0; bj < 2; ++bj)
#pragma unroll
                        for (int n = 0; n < 2; ++n) { const f32x4 v = acc[ai][bj][2 + j][n];
                            *(PG8_LAS f32x4*)(halw + ai * 4096 + j * 1024 + bj * 512 + n * 16) = v;
                            if (s == 3) *(f32x4*)(side + ((size_t)(u.pm * 4 + 2 + j) * NUPC + u.pn * BM + bj * HALF + cl + 4 * n)) = v; } }
        }
        asm volatile("s_waitcnt lgkmcnt(0)" ::: "memory"); __builtin_amdgcn_s_barrier(); asm volatile("" ::: "memory");
        const int ch0 = u.pn * HALF + cl;
#pragma unroll
        for (int ai = 0; ai < 2; ++ai) { const int s = 2 * ai + wr;
#pragma unroll
            for (int n = 0; n < 2; ++n) {
                unsigned wv[4][2];
#pragma unroll
                for (int ep = 0; ep < 2; ++ep) {
                    float yv[2][4][2];
#pragma unroll
                    for (int bj = 0; bj < 2; ++bj) {
                        const PG8_LAS float* wl = cwl + bj * HALF + cl + 4 * n + 2 * ep;
                        const f32x2 w0 = *(const PG8_LAS f32x2*)(wl), w1 = *(const PG8_LAS f32x2*)(wl + 256), w2 = *(const PG8_LAS f32x2*)(wl + 512);
                        f32x2 H1 = {0.f, 0.f}, H2 = {0.f, 0.f};
                        if (s > 0 && fr == 0) { H1 = *(const PG8_LAS f32x2*)(halr + ai * 4096 + 1024 + bj * 512 + n * 16 + ep * 8); H2 = *(const PG8_LAS f32x2*)(halr + ai * 4096 + bj * 512 + n * 16 + ep * 8); }
#pragma unroll
                        for (int e = 0; e < 2; ++e) {
                            const float a0 = acc[ai][bj][0][n][2 * ep + e], a1 = acc[ai][bj][1][n][2 * ep + e], a2 = acc[ai][bj][2][n][2 * ep + e], a3 = acc[ai][bj][3][n][2 * ep + e];
                            float y0 = w2[e] * a0 + w1[e] * H1[e] + w0[e] * H2[e];
                            float y1 = w2[e] * a1 + w1[e] * a0 + w0[e] * H1[e];
                            const float y2 = w2[e] * a2 + w1[e] * a1 + w0[e] * a0;
                            const float y3 = w2[e] * a3 + w1[e] * a2 + w0[e] * a1;
                            asm volatile("s_nop 1\n\t"
                                         "v_fmac_f32_dpp %0, %3, %4 row_shr:1 row_mask:0xf bank_mask:0xf bound_ctrl:0\n\t"
                                         "v_fmac_f32_dpp %0, %2, %5 row_shr:1 row_mask:0xf bank_mask:0xf bound_ctrl:0\n\t"
                                         "v_fmac_f32_dpp %1, %3, %5 row_shr:1 row_mask:0xf bank_mask:0xf bound_ctrl:0"
                                         : "+v"(y0), "+v"(y1)
                                         : "v"(a2), "v"(a3), "v"(w1[e]), "v"(w0[e]));
                            yv[bj][0][e] = y0; yv[bj][1][e] = y1; yv[bj][2][e] = y2; yv[bj][3][e] = y3;
                        }
                    }
#pragma unroll
                    for (int m = 0; m < 4; ++m) {
                        wv[m][ep] = cvt_pk_bf16(silu_f(yv[0][m][0]) * yv[1][m][0], silu_f(yv[0][m][1]) * yv[1][m][1]);
                        if (m < 2 && s == 0 && fr == 0) {
                            *(f32x2*)(side + ((size_t)(u.pm * 4 + m) * NUPC + u.pn * BM + cl + 4 * n + 2 * ep)) = (f32x2){yv[0][m][0], yv[0][m][1]};
                            *(f32x2*)(side + ((size_t)(u.pm * 4 + m) * NUPC + u.pn * BM + HALF + cl + 4 * n + 2 * ep)) = (f32x2){yv[1][m][0], yv[1][m][1]}; }
                    }
                    asm volatile("" ::: "memory"); __builtin_amdgcn_sched_barrier(0);
                }
#pragma unroll
                for (int m = 0; m < 4; ++m) {
                    const int row = u.pm * BM + ai * HALF + wr * 64 + 4 * fr + m;
                    u32x2 w; w.x = wv[m][0]; w.y = wv[m][1];
                    *(u32x2*)(act + (size_t)row * DFFC + ch0 + 4 * n) = w;
                }
                asm volatile("" ::: "memory"); __builtin_amdgcn_sched_barrier(0);
            }
        }
    }
};

template <class Epi, class Sched, bool ALIGN_EPI = false, bool SP2 = false>
__device__ __forceinline__ void gemm_phase(PG8_LAS unsigned char* lds, const Gemm g, const Sched& S, const Epi& E) {
    const int tid = opaque_tid(), wid = __builtin_amdgcn_readfirstlane(tid >> 6), lane = tid & 63, wr = wid >> 2, wc = wid & 3, fr = lane & 15, fq = lane >> 4;
    const int K = g.K, nt = K / BK;
    unsigned voffA[2], voffB[2];
#pragma unroll
    for (int i = 0; i < 2; ++i) { int R, C; stage_rc(tid * 16 + i * 8192, R, C); const int Rb = Epi::PERM ? ((R & ~31) + perm32(R & 31)) : R;
        const int Ra = Epi::PERMA ? ((R & ~63) + 4 * (R & 15) + ((R >> 4) & 3)) : R;
        voffA[i] = (unsigned)(Ra * K + C) * 2u; voffB[i] = (unsigned)(Rb * K + C) * 2u; }
    const size_t kstep = (size_t)(BK * 2);
    const size_t hstep = (size_t)HALF * K * 2;
    const size_t tstep = 2 * hstep;
    const unsigned ldsw = (unsigned)wid * 1024u;
    const int aoff = lds_byte(wr * 64 + fr, fq * 8), boff = lds_byte(wc * 32 + fr, fq * 8);
#define PG8_SA(b, h) (((b) * 2 + (h)) * HTB)
#define PG8_SB(b, h) ((4 + (b) * 2 + (h)) * HTB)
#define PG8_STAGE(bufoff, gbase, voff) do { _Pragma("unroll") for (int _i = 0; _i < 2; ++_i) \
        __builtin_amdgcn_global_load_lds((const unsigned*)((const char*)(gbase) + (voff)[_i]), (PG8_LAS unsigned*)(lds + (bufoff) + ldsw + _i * 8192), 16, 0, 0); } while (0)
#define PG8_LDA(dst, b, h) do { _Pragma("unroll") for (int m = 0; m < 4; ++m) _Pragma("unroll") for (int k = 0; k < 2; ++k) dst[m][k] = *(const PG8_LAS bf16x8*)(lds + PG8_SA(b, h) + aoff + m * 2048 + k * 1024); } while (0)
#define PG8_LDB(dst, b, h) do { _Pragma("unroll") for (int n = 0; n < 2; ++n) _Pragma("unroll") for (int k = 0; k < 2; ++k) dst[n][k] = *(const PG8_LAS bf16x8*)(lds + PG8_SB(b, h) + boff + n * 2048 + k * 1024); } while (0)
#define PG8_MMA(ai, bj, At, Bt) do { __builtin_amdgcn_s_setprio(3); _Pragma("unroll") for (int m = 0; m < 4; ++m) _Pragma("unroll") for (int n = 0; n < 2; ++n) _Pragma("unroll") for (int k = 0; k < 2; ++k) \
        acc[ai][bj][m][n] = __builtin_amdgcn_mfma_f32_16x16x32_bf16(Bt[n][k], At[m][k], acc[ai][bj][m][n], 0, 0, 0); __builtin_amdgcn_s_setprio(0); } while (0)
#define PG8_WAIT_V(n) asm volatile("s_waitcnt vmcnt(" #n ")" ::: "memory")
#define PG8_WAIT_L(n) asm volatile("s_waitcnt lgkmcnt(" #n ")" ::: "memory")
#define PG8_BAR __builtin_amdgcn_s_barrier()
#define PG8_SCHED __builtin_amdgcn_sched_barrier(0)
    Unit cur, nxt; int ui = 0;
    if (!S.next(0, cur)) return;
    f32x4 acc[2][2][4][2];
    if constexpr (Epi::HOOK) E.begin_unit(cur, 0, wid, lane);
    if constexpr (Epi::INIT) E.init(acc, cur, wr, wc, fr, fq);
    else {
#pragma unroll
    for (int a = 0; a < 2; ++a)
#pragma unroll
        for (int b = 0; b < 2; ++b)
#pragma unroll
            for (int m = 0; m < 4; ++m)
#pragma unroll
                for (int n = 0; n < 2; ++n) acc[a][b][m][n] = (f32x4){0.f, 0.f, 0.f, 0.f};
    }
    bf16x8 At[4][2], B0[2][2], B1[2][2];
    const char* cA = (const char*)g.A + (size_t)cur.pm * tstep; const char* cB = (const char*)g.Bt + (size_t)cur.pn * tstep;
    S.a_ready(cur);
    if constexpr (SP2) {
        PG8_STAGE(PG8_SB(0, 0), cB, voffB); PG8_STAGE(PG8_SB(0, 1), cB + hstep, voffB); PG8_STAGE(PG8_SA(0, 0), cA, voffA); PG8_STAGE(PG8_SA(0, 1), cA + hstep, voffA);
        if (wr == 1) PG8_BAR;
        PG8_WAIT_V(2); PG8_BAR;
        PG8_STAGE(PG8_SB(1, 0), cB + kstep, voffB); PG8_STAGE(PG8_SA(1, 0), cA + kstep, voffA); PG8_STAGE(PG8_SB(1, 1), cB + hstep + kstep, voffB);
        PG8_WAIT_V(6); PG8_BAR;
    } else {
        PG8_STAGE(PG8_SB(0, 0), cB, voffB); PG8_STAGE(PG8_SA(0, 0), cA, voffA); PG8_STAGE(PG8_SB(0, 1), cB + hstep, voffB); PG8_STAGE(PG8_SA(0, 1), cA + hstep, voffA);
        if (wr == 1) PG8_BAR;
        PG8_WAIT_V(4); PG8_BAR;
        PG8_STAGE(PG8_SB(1, 0), cB + kstep, voffB); PG8_STAGE(PG8_SA(1, 0), cA + kstep, voffA); PG8_STAGE(PG8_SB(1, 1), cB + hstep + kstep, voffB);
        PG8_WAIT_V(6); PG8_BAR;
    }
    for (;;) {
        const bool has_next = S.next(ui + 1, nxt);
        const char* nA = has_next ? (const char*)g.A + (size_t)nxt.pm * tstep : cA; const char* nB = has_next ? (const char*)g.Bt + (size_t)nxt.pn * tstep : cB;
        for (int t = 0; t < nt; t += 2) {
            const bool last = (t == nt - 2);
            const char* a1 = cA + (size_t)(t + 1) * kstep;
            const char* a2 = last ? nA : cA + (size_t)(t + 2) * kstep; const char* b2 = last ? nB : cB + (size_t)(t + 2) * kstep;
            const char* a3 = a2 + kstep; const char* b3 = b2 + kstep;
            if (last && has_next) S.a_ready(nxt);
            if constexpr (SP2) {
            PG8_LDB(B0, 0, 0); PG8_LDB(B1, 0, 1); PG8_SCHED; PG8_LDA(At, 0, 0); PG8_STAGE(PG8_SA(1, 1), a1 + hstep, voffA);
            PG8_WAIT_V(8); PG8_WAIT_L(0); PG8_BAR; PG8_MMA(0, 0, At, B0); PG8_MMA(0, 1, At, B1); PG8_BAR; PG8_SCHED;
            PG8_LDA(At, 0, 1); PG8_STAGE(PG8_SB(0, 0), b2, voffB); PG8_STAGE(PG8_SB(0, 1), b2 + hstep, voffB); PG8_STAGE(PG8_SA(0, 0), a2, voffA);
            PG8_WAIT_V(8); PG8_WAIT_L(0); PG8_BAR; PG8_MMA(1, 0, At, B0); PG8_MMA(1, 1, At, B1); PG8_BAR; PG8_SCHED;
            PG8_LDB(B0, 1, 0); PG8_LDB(B1, 1, 1); PG8_SCHED; PG8_LDA(At, 1, 0); PG8_STAGE(PG8_SA(0, 1), a2 + hstep, voffA);
            PG8_WAIT_V(8); PG8_WAIT_L(0); PG8_BAR; PG8_MMA(0, 0, At, B0); PG8_MMA(0, 1, At, B1); PG8_BAR; PG8_SCHED;
            PG8_LDA(At, 1, 1); PG8_STAGE(PG8_SB(1, 0), b3, voffB); PG8_STAGE(PG8_SB(1, 1), b3 + hstep, voffB); PG8_STAGE(PG8_SA(1, 0), a3, voffA);
            PG8_WAIT_V(8); PG8_WAIT_L(0); PG8_BAR; PG8_MMA(1, 0, At, B0); PG8_MMA(1, 1, At, B1); PG8_BAR; PG8_SCHED;
            } else {
            PG8_LDB(B0, 0, 0); PG8_SCHED; PG8_LDA(At, 0, 0); PG8_STAGE(PG8_SA(1, 1), a1 + hstep, voffA);
            PG8_WAIT_L(8); PG8_BAR; PG8_WAIT_L(0); PG8_MMA(0, 0, At, B0); PG8_BAR; PG8_SCHED;
            PG8_LDB(B1, 0, 1); PG8_STAGE(PG8_SB(0, 0), b2, voffB);
            PG8_BAR; PG8_WAIT_L(0); PG8_MMA(0, 1, At, B1); PG8_BAR;
            PG8_LDA(At, 0, 1); PG8_STAGE(PG8_SA(0, 0), a2, voffA);
            PG8_BAR; PG8_WAIT_L(0); PG8_MMA(1, 0, At, B0); PG8_BAR; PG8_SCHED;
            PG8_STAGE(PG8_SB(0, 1), b2 + hstep, voffB);
            PG8_WAIT_V(6); PG8_BAR; PG8_MMA(1, 1, At, B1); PG8_BAR;
            PG8_LDB(B0, 1, 0); PG8_SCHED; PG8_LDA(At, 1, 0); PG8_STAGE(PG8_SA(0, 1), a2 + hstep, voffA);
            PG8_WAIT_L(8); PG8_BAR; PG8_WAIT_L(0); PG8_MMA(0, 0, At, B0); PG8_BAR; PG8_SCHED;
            PG8_LDB(B1, 1, 1); PG8_STAGE(PG8_SB(1, 0), b3, voffB);
            PG8_BAR; PG8_WAIT_L(0); PG8_MMA(0, 1, At, B1); PG8_BAR;
            PG8_LDA(At, 1, 1); PG8_STAGE(PG8_SA(1, 0), a3, voffA);
            PG8_BAR; PG8_WAIT_L(0); PG8_MMA(1, 0, At, B0); PG8_BAR; PG8_SCHED;
            PG8_STAGE(PG8_SB(1, 1), b3 + hstep, voffB);
            PG8_WAIT_V(6); PG8_BAR; PG8_MMA(1, 1, At, B1); PG8_BAR;
            }
        }
        if constexpr (ALIGN_EPI) { if (wr == 0) PG8_BAR; }
        if constexpr (!Epi::AFTER_DRAIN) { if constexpr (Epi::HOOK) E(acc, cur, wr, wc, fr, fq, ui); else E(acc, cur, wr, wc, fr, fq); S.done(cur); }
        if (!has_next) break;
        if constexpr (Epi::HOOK) E.begin_unit(nxt, ui + 1, wid, lane);
        if constexpr (Epi::INIT) E.init(acc, nxt, wr, wc, fr, fq);
        else {
#pragma unroll
        for (int a = 0; a < 2; ++a)
#pragma unroll
            for (int b = 0; b < 2; ++b)
#pragma unroll
                for (int m = 0; m < 4; ++m)
#pragma unroll
                    for (int n = 0; n < 2; ++n) acc[a][b][m][n] = (f32x4){0.f, 0.f, 0.f, 0.f};
        }
        cur = nxt; cA = nA; cB = nB; ++ui;
        if constexpr (ALIGN_EPI) { if (wr == 1) PG8_BAR; }
    }
    PG8_WAIT_V(0);
    if constexpr (!ALIGN_EPI) { if (wr == 0) PG8_BAR; }
    PG8_BAR;
#undef PG8_SA
#undef PG8_SB
#undef PG8_STAGE
#undef PG8_LDA
#undef PG8_LDB
#undef PG8_MMA
#undef PG8_WAIT_V
#undef PG8_WAIT_L
#undef PG8_BAR
#undef PG8_SCHED
}
}

#define LAS __attribute__((address_space(3)))
typedef unsigned short bf16;
typedef short bf16x8 __attribute__((ext_vector_type(8)));
typedef float f32x4 __attribute__((ext_vector_type(4)));
typedef float f32x2 __attribute__((ext_vector_type(2)));
typedef float f32x16 __attribute__((ext_vector_type(16)));
typedef unsigned u32x4 __attribute__((ext_vector_type(4)));
typedef unsigned u32x2 __attribute__((ext_vector_type(2)));
typedef __bf16 bf16x2_t __attribute__((ext_vector_type(2)));

constexpr int SEQ = 2048, BATCH = 8, DM = 2048, M = BATCH * SEQ, DFF = 5632, NUP = 2 * DFF, NIN0 = 6144, NIN1 = 5120, LDW1 = 5128;
constexpr float EPS = 1e-6f;
constexpr float ATT_SCALE = 0.08838834764831845f;
constexpr size_t MiB = 1u << 20;
constexpr size_t WS_FLOG = 1 * MiB, WS_SIDE = 2 * MiB;
constexpr size_t WS_WIN0 = 16 * MiB, WS_WOUT0 = 40 * MiB, WS_WUP0 = 48 * MiB, WS_WDN0 = 92 * MiB;
constexpr size_t WS_WIN1 = 114 * MiB, WS_WOUT1 = 134 * MiB, WS_WUP1 = 142 * MiB, WS_WDN1 = 186 * MiB;
constexpr size_t WS_H = 208 * MiB;
constexpr size_t WS_P = 272 * MiB;
constexpr size_t WS_HB2 = 448 * MiB;
constexpr size_t WS_SSQ = 14 * MiB;
constexpr size_t WS_END = 512 * MiB;
constexpr int LDS_BYTES = 147456, HAL_OFF = 131072, MISC_OFF = HAL_OFF + 8192;
constexpr size_t CTL_ZERO_BYTES = 16384;

struct Params { const float* in[21]; float* out; unsigned char* ws; };

__device__ __forceinline__ unsigned pk2(float lo, float hi) { f32x2 v = {lo, hi}; bf16x2_t b = __builtin_convertvector(v, bf16x2_t); return __builtin_bit_cast(unsigned, b); }
__device__ __forceinline__ float bf2f(unsigned short b) { return __uint_as_float((unsigned)b << 16); }
__device__ __forceinline__ float bflo(unsigned w) { return __uint_as_float(w << 16); }
__device__ __forceinline__ float bfhi(unsigned w) { return __uint_as_float(w & 0xffff0000u); }
__device__ __forceinline__ float wave_sum(float v) {
#pragma unroll
    for (int o = 1; o < 64; o <<= 1) v += __shfl_xor(v, o);
    return v;
}
__device__ __forceinline__ int crow(int r, int hi) { return (r & 3) + 8 * (r >> 2) + 4 * hi; }
#define MFMA32(a, b, c) __builtin_amdgcn_mfma_f32_32x32x16_bf16((a), (b), (c), 0, 0, 0)


#define XB_TMO      128
#define XB_XCNT(j)  (256  + 64 * (j))
#define XB_XSUB(j)  (1280 + 64 * (j))
#define XB_XGEN(j)  (2304 + 64 * (j))
#define XB_TOP      3328
#define XB_TOPGEN   3392
#define XCD_BAR_WORDS 3456
#define XB_SPIN_CAP (1u << 30)
__device__ __forceinline__ unsigned xb_ld(unsigned* p)              { return __hip_atomic_load(p, __ATOMIC_RELAXED, __HIP_MEMORY_SCOPE_AGENT); }
__device__ __forceinline__ unsigned xb_add(unsigned* p, unsigned v) { return __hip_atomic_fetch_add(p, v, __ATOMIC_RELAXED, __HIP_MEMORY_SCOPE_AGENT); }
__device__ __forceinline__ unsigned xb_xcc_id() { return (unsigned)__builtin_amdgcn_s_getreg((3 << 11) | 20) & 0xFu; }
#define XB_SPIN(cond, bar) do { unsigned _sp = 0; while (cond) { __builtin_amdgcn_s_sleep(1); \
    if ((++_sp & 255u) == 0u) { if (xb_ld(&(bar)[XB_TMO])) break; if (_sp > XB_SPIN_CAP) { atomicAdd(&(bar)[XB_TMO], 1u); break; } } } } while (0)
struct XcdBarrier { unsigned* bar; unsigned x; volatile LAS unsigned* st; };
__device__ __forceinline__ XcdBarrier xcd_barrier_post(unsigned* bar, volatile LAS unsigned* st) {
    XcdBarrier b; b.bar = bar; b.x = xb_xcc_id(); b.st = st;
    if (threadIdx.x == 0) (void)xb_add(&bar[XB_XCNT(b.x)], 1u);
    return b;
}
__device__ __forceinline__ void xcd_barrier_complete(unsigned* bar, unsigned x, unsigned& nloc, unsigned& nx) {
    const unsigned G = gridDim.x * gridDim.y * gridDim.z;
    unsigned sum, cnt, mine, sp = 0u;
    for (;;) {
        sum = 0u; cnt = 0u; mine = 0u;
#pragma unroll
        for (unsigned j = 0; j < 16; ++j) { const unsigned c = xb_ld(&bar[XB_XCNT(j)]); sum += c; cnt += (c > 0u) ? 1u : 0u; mine = (j == x) ? c : mine; }
        if (sum == G) break;
        __builtin_amdgcn_s_sleep(1);
        if ((++sp & 255u) == 0u) { if (xb_ld(&bar[XB_TMO])) break; if (sp > XB_SPIN_CAP) { atomicAdd(&bar[XB_TMO], 1u); break; } }
    }
    nloc = mine > 0u ? mine : 1u; nx = cnt > 0u ? cnt : 1u;
}
__device__ __forceinline__ void xcd_barrier(const XcdBarrier& b) {
    asm volatile("s_waitcnt vmcnt(0)" ::: "memory");
    __syncthreads();
    if (threadIdx.x == 0) {
        unsigned* bar = b.bar;
        __builtin_amdgcn_s_waitcnt(0);
        unsigned nloc = b.st[0], nx = b.st[1];
        if (nloc == 0u) { xcd_barrier_complete(bar, b.x, nloc, nx); b.st[0] = nloc; b.st[1] = nx; }
        const unsigned old = xb_add(&bar[XB_XSUB(b.x)], 1u);
        const unsigned gen = old / nloc;
        if (old + 1u == (gen + 1u) * nloc) {
            __builtin_amdgcn_fence(__ATOMIC_RELEASE, "agent");
            asm volatile("s_waitcnt vmcnt(0)" ::: "memory");
            const unsigned og = xb_add(&bar[XB_TOP], 1u);
            const unsigned tg = og / nx;
            if (og + 1u == (tg + 1u) * nx) xb_add(&bar[XB_TOPGEN], 1u);
            else XB_SPIN(xb_ld(&bar[XB_TOPGEN]) == tg, bar);
            __builtin_amdgcn_fence(__ATOMIC_ACQUIRE, "agent");
            xb_add(&bar[XB_XGEN(b.x)], 1u);
            asm volatile("s_waitcnt vmcnt(0)" ::: "memory");
        } else {
            XB_SPIN(xb_ld(&bar[XB_XGEN(b.x)]) == gen, bar);
            __builtin_amdgcn_fence(__ATOMIC_ACQUIRE, "agent");
            asm volatile("s_waitcnt vmcnt(0)" ::: "memory");
        }
    }
    __syncthreads();
}


__device__ __forceinline__ void ctr_barrier(unsigned* cnt, unsigned target) {
    asm volatile("s_waitcnt vmcnt(0)" ::: "memory");
    __syncthreads();
    if (threadIdx.x == 0) {
        __builtin_amdgcn_fence(__ATOMIC_RELEASE, "agent");
        asm volatile("s_waitcnt vmcnt(0)" ::: "memory");
        (void)__hip_atomic_fetch_add(cnt, 1u, __ATOMIC_RELAXED, __HIP_MEMORY_SCOPE_AGENT);
        while (__hip_atomic_load(cnt, __ATOMIC_RELAXED, __HIP_MEMORY_SCOPE_AGENT) < target) __builtin_amdgcn_s_sleep(1);
        __builtin_amdgcn_fence(__ATOMIC_ACQUIRE, "agent");
        asm volatile("s_waitcnt vmcnt(0)" ::: "memory");
    }
    __syncthreads();
}

template <int MAP>
__device__ __forceinline__ void transpose_item(const float* __restrict__ W, int K, int ldw, int nblk, bf16* __restrict__ WT, LAS float* scr, int item, int lane, const float* __restrict__ gk = nullptr) {
    const int kb = item / nblk, nb = item % nblk, k0 = 64 * kb, n0 = 32 * nb;
#pragma unroll 8
    for (int i = 0; i < 8; ++i) { const int kk = 8 * i + (lane >> 3), n4 = (lane & 7) * 4; f32x4 w = *(const f32x4*)(W + (size_t)(k0 + kk) * ldw + n0 + n4); if (MAP == 1) w = w * gk[k0 + kk];
        scr[kk * 33 + n4] = w[0]; scr[kk * 33 + n4 + 1] = w[1]; scr[kk * 33 + n4 + 2] = w[2]; scr[kk * 33 + n4 + 3] = w[3]; }
    asm volatile("s_waitcnt lgkmcnt(0)" ::: "memory");
    int rb = n0;
    if (MAP == 1) { rb = (n0 < DFF) ? ((n0 >> 7) * 256 + (n0 & 127)) : ((((n0 - DFF) >> 7) * 256) + 128 + ((n0 - DFF) & 127)); }
    const int c = lane & 7;
#pragma unroll
    for (int j = 0; j < 4; ++j) { const int n = (lane >> 3) + 8 * j; const LAS float* s = scr + (8 * c) * 33 + n;
        u32x4 o; o.x = pk2(s[0 * 33], s[1 * 33]); o.y = pk2(s[2 * 33], s[3 * 33]); o.z = pk2(s[4 * 33], s[5 * 33]); o.w = pk2(s[6 * 33], s[7 * 33]);
        *(u32x4*)(WT + (size_t)(rb + n) * K + k0 + 8 * c) = o; }
    asm volatile("s_waitcnt lgkmcnt(0)" ::: "memory");
}

template <int MODE>
__device__ __forceinline__ void rms_rows(const float* X, const float* __restrict__ g, bf16* H, float* OutF, const LAS float* WfT, float* flog, int gw, int ngw, int lane) {
    f32x4 gv[8];
#pragma unroll
    for (int j = 0; j < 8; ++j) gv[j] = ((const f32x4*)g)[64 * j + lane];
    for (int m = gw; m < M; m += ngw) {
        const f32x4* xr = (const f32x4*)(X + (size_t)m * DM) + lane;
        f32x4 v[8]; float ss = 0.f;
#pragma unroll
        for (int j = 0; j < 8; ++j) { v[j] = xr[64 * j]; ss += (v[j].x * v[j].x + v[j].y * v[j].y) + (v[j].z * v[j].z + v[j].w * v[j].w); }
        const float rs = 1.0f / sqrtf(wave_sum(ss) * (1.0f / DM) + EPS);
#pragma unroll
        for (int j = 0; j < 8; ++j) v[j] = v[j] * rs * gv[j];
        if (MODE == 2) {
            f32x4* o = (f32x4*)(OutF + (size_t)m * DM) + lane;
#pragma unroll
            for (int j = 0; j < 8; ++j) o[64 * j] = v[j];
        } else {
            u32x2* o = (u32x2*)(H + (size_t)m * DM) + lane;
#pragma unroll
            for (int j = 0; j < 8; ++j) { u32x2 w; w.x = pk2(v[j].x, v[j].y); w.y = pk2(v[j].z, v[j].w); o[64 * j] = w; }
        }
        if (MODE == 1) {
            float a8[8];
#pragma unroll
            for (int jj = 0; jj < 8; ++jj) a8[jj] = 0.f;
#pragma unroll
            for (int j = 0; j < 8; ++j) {
#pragma unroll
                for (int jj = 0; jj < 8; ++jj) { const f32x4 w = *(const LAS f32x4*)(WfT + jj * DM + 4 * (64 * j + lane)); a8[jj] += (v[j].x * w.x + v[j].y * w.y) + (v[j].z * w.z + v[j].w * w.w); }
                asm volatile("" ::: "memory");
            }
            float mine = 0.f;
#pragma unroll
            for (int jj = 0; jj < 8; ++jj) { const float a = wave_sum(a8[jj]); if (lane == jj) mine = a; }
            if (lane < 8) flog[(size_t)m * 8 + lane] = mine;
        }
    }
}

__device__ __forceinline__ float wave_sum8(const float (&a8)[8], int lane) {
    const bool b2 = (lane & 4) != 0, b1 = (lane & 2) != 0, b0 = (lane & 1) != 0;
    float bq[4], cq[2], r;
#pragma unroll
    for (int i = 0; i < 4; ++i) { const float snd = b2 ? a8[i] : a8[i + 4]; const float rcv = __shfl_xor(snd, 4); bq[i] = (b2 ? a8[i + 4] : a8[i]) + rcv; }
#pragma unroll
    for (int i = 0; i < 2; ++i) { const float snd = b1 ? bq[i] : bq[i + 2]; const float rcv = __shfl_xor(snd, 2); cq[i] = (b1 ? bq[i + 2] : bq[i]) + rcv; }
    { const float snd = b0 ? cq[0] : cq[1]; const float rcv = __shfl_xor(snd, 1); r = (b0 ? cq[1] : cq[0]) + rcv; }
    r += __shfl_xor(r, 8); r += __shfl_xor(r, 16); r += __shfl_xor(r, 32);
    return r;
}
__device__ __forceinline__ void rms1_rows_bf16(const bf16* Xb, const float* __restrict__ ssq, const float* __restrict__ g, bf16* H, const LAS float* WfT, float* flog, int gw, int ngw, int lane) {
    f32x4 gv[8];
#pragma unroll
    for (int j = 0; j < 8; ++j) gv[j] = ((const f32x4*)g)[64 * j + lane];
    for (int m = gw; m < M; m += 2 * ngw) {
        const bool two = (m + ngw) < M; const int mB = two ? m + ngw : m;
        const float partA = (lane < 32) ? ssq[(size_t)m * 32 + lane] : 0.f, partB = (lane < 32) ? ssq[(size_t)mB * 32 + lane] : 0.f;
        const u32x2* xrA = (const u32x2*)(Xb + (size_t)m * DM) + lane; const u32x2* xrB = (const u32x2*)(Xb + (size_t)mB * DM) + lane;
        u32x2 xa[8], xb[8];
#pragma unroll
        for (int j = 0; j < 8; ++j) { xa[j] = xrA[64 * j]; xb[j] = xrB[64 * j]; }
        const float rsA = 1.0f / sqrtf(wave_sum(partA) * (1.0f / DM) + EPS), rsB = 1.0f / sqrtf(wave_sum(partB) * (1.0f / DM) + EPS);
        f32x4 vA[8], vB[8];
#pragma unroll
        for (int j = 0; j < 8; ++j) {
            vA[j].x = bflo(xa[j].x); vA[j].y = bfhi(xa[j].x); vA[j].z = bflo(xa[j].y); vA[j].w = bfhi(xa[j].y); vA[j] = vA[j] * rsA * gv[j];
            vB[j].x = bflo(xb[j].x); vB[j].y = bfhi(xb[j].x); vB[j].z = bflo(xb[j].y); vB[j].w = bfhi(xb[j].y); vB[j] = vB[j] * rsB * gv[j]; }
        { u32x2* o = (u32x2*)(H + (size_t)m * DM) + lane;
#pragma unroll
          for (int j = 0; j < 8; ++j) { u32x2 w; w.x = pk2(vA[j].x, vA[j].y); w.y = pk2(vA[j].z, vA[j].w); o[64 * j] = w; } }
        if (two) { u32x2* o = (u32x2*)(H + (size_t)mB * DM) + lane;
#pragma unroll
          for (int j = 0; j < 8; ++j) { u32x2 w; w.x = pk2(vB[j].x, vB[j].y); w.y = pk2(vB[j].z, vB[j].w); o[64 * j] = w; } }
        float aA[8], aB[8];
#pragma unroll
        for (int jj = 0; jj < 8; ++jj) { aA[jj] = 0.f; aB[jj] = 0.f; }
#pragma unroll
        for (int j = 0; j < 8; ++j) {
#pragma unroll
            for (int jj = 0; jj < 8; ++jj) { const f32x4 w = *(const LAS f32x4*)(WfT + jj * DM + 4 * (64 * j + lane));
                aA[jj] += (vA[j].x * w.x + vA[j].y * w.y) + (vA[j].z * w.z + vA[j].w * w.w);
                aB[jj] += (vB[j].x * w.x + vB[j].y * w.y) + (vB[j].z * w.z + vB[j].w * w.w); }
            asm volatile("" ::: "memory");
        }
        const float mineA = wave_sum8(aA, lane), mineB = wave_sum8(aB, lane);
        if (lane < 8) { flog[(size_t)m * 8 + lane] = mineA; if (two) flog[(size_t)mB * 8 + lane] = mineB; }
    }
}

constexpr int KS_PITCH = 272, VT_PITCH = 144, KBUF = 64 * KS_PITCH, VBUF = 128 * VT_PITCH, KS_OFF = 0, VT_OFF = 2 * KBUF, CS_OFF = VT_OFF + 2 * VBUF, SCAN_OFF = CS_OFF + 8192;
struct KVRegs { u32x4 k[2]; u32x4 v[2]; };
__device__ __forceinline__ void kv_load(KVRegs& R, const bf16* Kg, const bf16* Vg, int ldp, int tid) {
#pragma unroll
    for (int i = 0; i < 2; ++i) { const int c = tid + 512 * i; R.k[i] = *(const u32x4*)(Kg + (size_t)(c >> 4) * ldp + (c & 15) * 8); }
    const int kp = tid & 31, dg = tid >> 5;
    R.v[0] = *(const u32x4*)(Vg + (size_t)(2 * kp) * ldp + dg * 8); R.v[1] = *(const u32x4*)(Vg + (size_t)(2 * kp + 1) * ldp + dg * 8);
}
__device__ __forceinline__ void kv_store(const KVRegs& R, LAS unsigned char* lds, int tid, int buf) {
#pragma unroll
    for (int i = 0; i < 2; ++i) { const int c = tid + 512 * i; *(LAS u32x4*)(lds + KS_OFF + buf * KBUF + (c >> 4) * KS_PITCH + (c & 15) * 16) = R.k[i]; }
    const int kp = tid & 31, dg = tid >> 5;
    const int kk_ = (2 * kp) & 15, g_ = kk_ >> 2, vpos = (((2 * kp) >> 4) * 16 + ((((g_ & 1) << 1) | (g_ >> 1)) * 4) + (kk_ & 3)) * 2;
#pragma unroll
    for (int i = 0; i < 8; ++i) { const unsigned a = (R.v[0][i >> 1] >> (16 * (i & 1))) & 0xffffu, b = (R.v[1][i >> 1] >> (16 * (i & 1))) & 0xffffu;
        *(LAS unsigned*)(lds + VT_OFF + buf * VBUF + (dg * 8 + i) * VT_PITCH + vpos) = a | (b << 16); }
}
__device__ __forceinline__ bf16x8 pack8(const f32x16& x, int s8) {
    u32x4 p; p.x = pk2(x[s8], x[s8 + 1]); p.y = pk2(x[s8 + 2], x[s8 + 3]); p.z = pk2(x[s8 + 4], x[s8 + 5]); p.w = pk2(x[s8 + 6], x[s8 + 7]);
    return __builtin_bit_cast(bf16x8, p);
}
__device__ __forceinline__ void pv_tile(f32x16 (&o)[4], const f32x16& p0, const f32x16& p1, const LAS unsigned char* vbase, int r32, int hh) {
    bf16x8 pf[4]; pf[0] = pack8(p0, 0); pf[1] = pack8(p0, 8); pf[2] = pack8(p1, 0); pf[3] = pack8(p1, 8);
#pragma unroll
    for (int db = 0; db < 4; ++db)
#pragma unroll
        for (int s = 0; s < 4; ++s) {
            const bf16x8 a = *(const LAS bf16x8*)(vbase + (db * 32 + r32) * VT_PITCH + (16 * s + 8 * hh) * 2);
            o[db] = MFMA32(a, pf[s], o[db]);
        }
}
__device__ __forceinline__ void qk_tile(f32x16& s0, f32x16& s1, const bf16x8 (&qf)[8], const LAS unsigned char* kbase, int r32, int hh) {
#pragma unroll
    for (int dh = 0; dh < 2; ++dh) {
        bf16x8 k0[4], k1[4];
#pragma unroll
        for (int d = 0; d < 4; ++d) { const int d0 = 4 * dh + d; k0[d] = *(const LAS bf16x8*)(kbase + r32 * KS_PITCH + d0 * 32 + hh * 16); k1[d] = *(const LAS bf16x8*)(kbase + (32 + r32) * KS_PITCH + d0 * 32 + hh * 16); }
        asm volatile("" ::: "memory");
#pragma unroll
        for (int d = 0; d < 4; ++d) { s0 = MFMA32(k0[d], qf[4 * dh + d], s0); s1 = MFMA32(k1[d], qf[4 * dh + d], s1); }
    }
}

constexpr float QSCALE2 = ATT_SCALE * 1.4426950408889634f, LOG2E = 1.4426950408889634f;
template <int MODE>
__device__ __forceinline__ void attn_item(LAS unsigned char* lds, const bf16* __restrict__ P, int ldp, int qoff, int koff, int voff, bf16* __restrict__ cat, int catoff,
                                          int b, int h, int qb, const float* __restrict__ flog, float bfh) {
    const int tid = opaque_tid(), lane = tid & 63, wid = __builtin_amdgcn_readfirstlane(tid >> 6), r32 = lane & 31, hh = lane >> 5;
    const size_t rowbase = (size_t)b * SEQ; const int q0 = qb * 256;
    const int t = q0 + wid * 32 + r32;
    const int wtmin = q0 + wid * 32, wtmax = wtmin + 31;
    LAS float* cs = (LAS float*)(lds + CS_OFF);
    __syncthreads();
    if (MODE == 1) {
        LAS float* sc = (LAS float*)(lds + SCAN_OFF);
        float v[4]; float run = 0.f;
#pragma unroll
        for (int i = 0; i < 4; ++i) { const float x = flog[(rowbase + tid * 4 + i) * 8 + h] + bfh; const float lf = fminf(x, 0.f) - __logf(1.0f + __expf(-fabsf(x))); run += lf; v[i] = run; }
        float incl = run;
#pragma unroll
        for (int o = 1; o < 64; o <<= 1) { const float y = __shfl_up(incl, o); if (lane >= o) incl += y; }
        if (lane == 63) sc[wid] = incl;
        __syncthreads();
        float base = incl - run;
        for (int w = 0; w < wid; ++w) base += sc[w];
#pragma unroll
        for (int i = 0; i < 4; ++i) cs[tid * 4 + i] = (base + v[i]) * LOG2E;
        __syncthreads();
    }
    bf16x8 qf[8];
    { const bf16* qp = P + (rowbase + t) * ldp + qoff + h * 128 + hh * 8;
#pragma unroll
      for (int d0 = 0; d0 < 8; ++d0) { const u32x4 q = *(const u32x4*)(qp + d0 * 16); u32x4 w;
#pragma unroll
          for (int e = 0; e < 4; ++e) w[e] = pk2(bflo(q[e]) * QSCALE2, bfhi(q[e]) * QSCALE2);
          qf[d0] = __builtin_bit_cast(bf16x8, w); } }
    f32x16 o[4];
#pragma unroll
    for (int db = 0; db < 4; ++db)
#pragma unroll
        for (int i = 0; i < 16; ++i) o[db][i] = 0.f;
    const bf16* Kh = P + rowbase * ldp + koff + h * 128; const bf16* Vh = P + rowbase * ldp + voff + h * 128;
    const int ntiles = (q0 + 256) / 64;
    float carry = 1.f;
    LAS unsigned* flg = (LAS unsigned*)(lds + SCAN_OFF);
    float mrun = -INFINITY, lsum = 0.f;
    const float ct = (MODE == 1) ? cs[t] : 0.f;
    KVRegs R;
    kv_load(R, Kh + (size_t)(ntiles - 1) * 64 * ldp, Vh + (size_t)(ntiles - 1) * 64 * ldp, ldp, tid);
    kv_store(R, lds, tid, 0);
    __syncthreads();
    for (int it = 0; it < ntiles; ++it) {
        const int jt = ntiles - 1 - it; const int kt0 = jt * 64; const int buf = it & 1;
        if (MODE == 0 && it > 0) { unsigned all = 1u;
#pragma unroll
            for (int w = 0; w < 8; ++w) all &= flg[(buf ^ 1) * 8 + w];
            if (all) break; }
        if (it + 1 < ntiles) kv_load(R, Kh + (size_t)(jt - 1) * 64 * ldp, Vh + (size_t)(jt - 1) * 64 * ldp, ldp, tid);
        const LAS unsigned char* kbase = lds + KS_OFF + buf * KBUF; const LAS unsigned char* vbase = lds + VT_OFF + buf * VBUF;
        if (kt0 > wtmax) { if (MODE == 0 && lane == 0) flg[buf * 8 + wid] = 0u; }
        else {
        f32x16 s0, s1;
        if (MODE == 0) {
#pragma unroll
            for (int i = 0; i < 16; ++i) { s0[i] = 0.f; s1[i] = 0.f; }
            qk_tile(s0, s1, qf, kbase, r32, hh);
            f32x16 L0, L1;
#pragma unroll
            for (int r = 0; r < 16; ++r) {
                { const float z = s0[r]; const float e = __builtin_amdgcn_exp2f(-fabsf(z)); const float rr = __builtin_amdgcn_rcpf(1.0f + e), er = e * rr; const bool pz = z >= 0.f; s0[r] = pz ? rr : er; L0[r] = pz ? er : rr; }
                { const float z = s1[r]; const float e = __builtin_amdgcn_exp2f(-fabsf(z)); const float rr = __builtin_amdgcn_rcpf(1.0f + e), er = e * rr; const bool pz = z >= 0.f; s1[r] = pz ? rr : er; L1[r] = pz ? er : rr; } }
            if (kt0 + 63 >= wtmin) {
#pragma unroll
                for (int r = 0; r < 16; ++r) { const int key = kt0 + crow(r, hh);
                    if (!(key < t)) { s0[r] = 0.f; L0[r] = 1.f; }
                    if (!(key + 32 < t)) { s1[r] = 0.f; L1[r] = 1.f; } }
            }
            float G0[4], G1[4], PG0[4], PG1[4], S0[4], S1[4];
#pragma unroll
            for (int g = 0; g < 4; ++g) { G0[g] = (L0[4 * g] * L0[4 * g + 1]) * (L0[4 * g + 2] * L0[4 * g + 3]); G1[g] = (L1[4 * g] * L1[4 * g + 1]) * (L1[4 * g + 2] * L1[4 * g + 3]); }
#pragma unroll
            for (int g = 0; g < 4; ++g) { PG0[g] = __shfl_xor(G0[g], 32); PG1[g] = __shfl_xor(G1[g], 32); }
            float run = carry;
#pragma unroll
            for (int g = 3; g >= 0; --g) { S1[g] = (hh == 0) ? run * PG1[g] : run; run *= G1[g] * PG1[g]; }
#pragma unroll
            for (int g = 3; g >= 0; --g) { S0[g] = (hh == 0) ? run * PG0[g] : run; run *= G0[g] * PG0[g]; }
            carry = run;
#pragma unroll
            for (int g = 0; g < 4; ++g) {
                float later0 = S0[g], later1 = S1[g];
#pragma unroll
                for (int e = 3; e >= 0; --e) { const int r = 4 * g + e;
                    s0[r] *= later0; later0 *= L0[r];
                    s1[r] *= later1; later1 *= L1[r]; }
            }
            { const bool wd = __all(carry == 0.f); if (lane == 0) flg[buf * 8 + wid] = wd ? 1u : 0u; }
        } else {
#pragma unroll
            for (int g = 0; g < 4; ++g) { const f32x4 c0 = *(const LAS f32x4*)(cs + kt0 + 8 * g + 4 * hh), c1 = *(const LAS f32x4*)(cs + kt0 + 32 + 8 * g + 4 * hh);
#pragma unroll
                for (int e = 0; e < 4; ++e) { s0[4 * g + e] = ct - c0[e]; s1[4 * g + e] = ct - c1[e]; } }
            qk_tile(s0, s1, qf, kbase, r32, hh);
            if (kt0 + 63 > wtmin) {
#pragma unroll
                for (int r = 0; r < 16; ++r) { const int key = kt0 + crow(r, hh);
                    if (key > t) s0[r] = -INFINITY;
                    if (key + 32 > t) s1[r] = -INFINITY; }
            }
            float mx = fmaxf(s0[0], s1[0]);
#pragma unroll
            for (int r = 1; r < 16; ++r) mx = fmaxf(fmaxf(mx, s0[r]), s1[r]);
            mx = fmaxf(mx, __shfl_xor(mx, 32));
            const float mnew = fmaxf(mrun, mx); const float muse = (mnew == -INFINITY) ? 0.f : mnew;
            const float alpha = __builtin_amdgcn_exp2f(mrun - muse);
            float ps = 0.f;
#pragma unroll
            for (int r = 0; r < 16; ++r) { s0[r] = __builtin_amdgcn_exp2f(s0[r] - muse); s1[r] = __builtin_amdgcn_exp2f(s1[r] - muse); ps += s0[r] + s1[r]; }
            lsum = lsum * alpha + ps; mrun = mnew;
            if (__any(alpha != 1.0f)) {
#pragma unroll
                for (int db = 0; db < 4; ++db)
#pragma unroll
                    for (int i = 0; i < 16; ++i) o[db][i] *= alpha; }
        }
        pv_tile(o, s0, s1, vbase, r32, hh);
        }
        if (it + 1 < ntiles) kv_store(R, lds, tid, buf ^ 1);
        __syncthreads();
    }
    float inv = 1.0f;
    if (MODE == 1) { const float lt = lsum + __shfl_xor(lsum, 32); inv = 1.0f / lt; }
    bf16* op = cat + (rowbase + t) * DM + catoff + h * 128;
#pragma unroll
    for (int db = 0; db < 4; ++db)
#pragma unroll
        for (int g = 0; g < 4; ++g) { u32x2 w; w.x = pk2(o[db][4 * g] * inv, o[db][4 * g + 1] * inv); w.y = pk2(o[db][4 * g + 2] * inv, o[db][4 * g + 3] * inv);
            *(u32x2*)(op + db * 32 + 8 * g + 4 * hh) = w; }
}

__device__ __forceinline__ void shortconv_phase(const bf16* __restrict__ P, const float* __restrict__ w, bf16* __restrict__ cat, size_t gt, size_t gs) {
    for (size_t i = gt; i < (size_t)(M / 8) * 128; i += gs) {
        const int cg8 = (int)(i & 127), m0 = (int)(i >> 7) * 8, tpos0 = m0 & (SEQ - 1), c0 = cg8 * 8;
        float w0[8], w1[8], w2[8];
        { const f32x4 a = *(const f32x4*)(w + c0), b = *(const f32x4*)(w + c0 + 4), c = *(const f32x4*)(w + 1024 + c0), d = *(const f32x4*)(w + 1024 + c0 + 4), e = *(const f32x4*)(w + 2048 + c0), f = *(const f32x4*)(w + 2048 + c0 + 4);
#pragma unroll
          for (int k = 0; k < 4; ++k) { w0[k] = a[k]; w0[4 + k] = b[k]; w1[k] = c[k]; w1[4 + k] = d[k]; w2[k] = e[k]; w2[4 + k] = f[k]; } }
        float p2[8], p1[8];
#pragma unroll
        for (int e = 0; e < 8; ++e) { p2[e] = 0.f; p1[e] = 0.f; }
        if (tpos0 >= 2) {
            const bf16* r2 = P + (size_t)(m0 - 2) * NIN0; const bf16* r1 = r2 + NIN0;
            const u32x4 gc2 = *(const u32x4*)(r2 + 4096 + c0), hn2 = *(const u32x4*)(r2 + 5120 + c0), gc1 = *(const u32x4*)(r1 + 4096 + c0), hn1 = *(const u32x4*)(r1 + 5120 + c0);
#pragma unroll
            for (int e = 0; e < 4; ++e) { p2[2 * e] = bflo(gc2[e]) * bflo(hn2[e]); p2[2 * e + 1] = bfhi(gc2[e]) * bfhi(hn2[e]); p1[2 * e] = bflo(gc1[e]) * bflo(hn1[e]); p1[2 * e + 1] = bfhi(gc1[e]) * bfhi(hn1[e]); }
        }
#pragma unroll
        for (int j = 0; j < 8; ++j) {
            const bf16* row = P + (size_t)(m0 + j) * NIN0;
            const u32x4 gb = *(const u32x4*)(row + 3072 + c0), gc = *(const u32x4*)(row + 4096 + c0), hn = *(const u32x4*)(row + 5120 + c0);
            float p0[8];
#pragma unroll
            for (int e = 0; e < 4; ++e) { p0[2 * e] = bflo(gc[e]) * bflo(hn[e]); p0[2 * e + 1] = bfhi(gc[e]) * bfhi(hn[e]); }
            u32x4 ow;
#pragma unroll
            for (int e = 0; e < 4; ++e) { const float y0 = w0[2 * e] * p2[2 * e] + w1[2 * e] * p1[2 * e] + w2[2 * e] * p0[2 * e], y1 = w0[2 * e + 1] * p2[2 * e + 1] + w1[2 * e + 1] * p1[2 * e + 1] + w2[2 * e + 1] * p0[2 * e + 1];
                ow[e] = pk2(bflo(gb[e]) * y0, bfhi(gb[e]) * y1); }
            *(u32x4*)(cat + (size_t)(m0 + j) * DM + 1024 + c0) = ow;
#pragma unroll
            for (int e = 0; e < 8; ++e) { p2[e] = p1[e]; p1[e] = p0[e]; }
        }
    }
}

__device__ __forceinline__ void gmlp_stats(LAS unsigned char* lds, const bf16* __restrict__ P, int b, int n) {
    const int tid = opaque_tid(), lane = tid & 63, wid = __builtin_amdgcn_readfirstlane(tid >> 6);
    const size_t row0 = (size_t)b * SEQ + (size_t)n * 128;
    LAS float* stat = (LAS float*)lds;
    __syncthreads();
#pragma unroll 1
    for (int hb = 0; hb < 2; ++hb) {
        u32x4 av[8], cv[8];
#pragma unroll
        for (int i = 0; i < 8; ++i) { const bf16* vp = P + (row0 + wid * 16 + hb * 8 + i) * NIN1 + 1024 + lane * 16; av[i] = *(const u32x4*)vp; cv[i] = *(const u32x4*)(vp + 8); }
#pragma unroll
        for (int i = 0; i < 8; ++i) { const int tk = wid * 16 + hb * 8 + i;
            float x[16];
#pragma unroll
            for (int e = 0; e < 4; ++e) { x[2 * e] = bflo(av[i][e]); x[2 * e + 1] = bfhi(av[i][e]); x[8 + 2 * e] = bflo(cv[i][e]); x[9 + 2 * e] = bfhi(cv[i][e]); }
            float sm = 0.f;
#pragma unroll
            for (int e = 0; e < 16; ++e) sm += x[e];
            const float mean = wave_sum(sm) * (1.0f / 1024.0f);
            float q = 0.f;
#pragma unroll
            for (int e = 0; e < 16; ++e) { const float d = x[e] - mean; q += d * d; }
            const float rstd = 1.0f / sqrtf(wave_sum(q) * (1.0f / 1024.0f) + EPS);
            if (lane == 0) { stat[2 * tk] = mean; stat[2 * tk + 1] = rstd; } }
    }
    __syncthreads();
}
__device__ __forceinline__ void gmlp_item(LAS unsigned char* lds, const bf16* __restrict__ P, const float* __restrict__ sgw, const float* __restrict__ sgb, const float* __restrict__ gn,
                                          bf16* __restrict__ cat, int b, int n, int g) {
    const int tid = opaque_tid(), lane = tid & 63, wid = __builtin_amdgcn_readfirstlane(tid >> 6), r32 = lane & 31, hh = lane >> 5;
    const size_t row0 = (size_t)b * SEQ + (size_t)n * 128;
    LAS float* stat = (LAS float*)lds;
    LAS unsigned char* vnT = lds + 1024;
    LAS unsigned char* Wl = lds + 1024 + 128 * 272;
    __syncthreads();
    f32x4 wa[4], wc[4]; u32x4 va[2], vc[2];
#pragma unroll
    for (int i = 0; i < 4; ++i) { const int task = tid + 512 * i, tt = task >> 4, s8 = (task & 15) * 8; const float* wp = sgw + ((size_t)g * 128 + tt) * 128 + s8; wa[i] = *(const f32x4*)wp; wc[i] = *(const f32x4*)(wp + 4); }
#pragma unroll
    for (int i = 0; i < 2; ++i) { const int task = tid + 512 * i, sp = task & 63, c8 = task >> 6; const bf16* vp = P + (row0 + 2 * sp) * NIN1 + 1024 + g * 128 + c8 * 8; va[i] = *(const u32x4*)vp; vc[i] = *(const u32x4*)(vp + NIN1); }
#pragma unroll
    for (int i = 0; i < 2; ++i) { const int task = tid + 512 * i, sp = task & 63, c8 = task >> 6;
        const u32x4 a = va[i], c = vc[i];
        const float m0 = stat[4 * sp], r0 = stat[4 * sp + 1], m1 = stat[4 * sp + 2], r1 = stat[4 * sp + 3];
        const f32x4 g0 = *(const f32x4*)(gn + g * 128 + c8 * 8), g1 = *(const f32x4*)(gn + g * 128 + c8 * 8 + 4);
#pragma unroll
        for (int e = 0; e < 8; ++e) { const float gg = (e < 4) ? g0[e & 3] : g1[e & 3];
            const float x0 = (e & 1) ? bfhi(a[e >> 1]) : bflo(a[e >> 1]), x1 = (e & 1) ? bfhi(c[e >> 1]) : bflo(c[e >> 1]);
            *(LAS unsigned*)(vnT + (c8 * 8 + e) * 272 + sp * 4) = pk2((x0 - m0) * r0 * gg, (x1 - m1) * r1 * gg); } }
#pragma unroll
    for (int i = 0; i < 4; ++i) { const int task = tid + 512 * i, tt = task >> 4, s8 = (task & 15) * 8;
        float x[8] = {wa[i].x, wa[i].y, wa[i].z, wa[i].w, wc[i].x, wc[i].y, wc[i].z, wc[i].w};
#pragma unroll
        for (int e = 0; e < 8; ++e) if (s8 + e > tt) x[e] = 0.f;
        u32x4 w; w.x = pk2(x[0], x[1]); w.y = pk2(x[2], x[3]); w.z = pk2(x[4], x[5]); w.w = pk2(x[6], x[7]);
        *(LAS u32x4*)(Wl + tt * 272 + s8 * 2) = w; }
    __syncthreads();
    const int tb = wid & 3, chf = wid >> 2;
    f32x16 acc[2];
#pragma unroll
    for (int cb = 0; cb < 2; ++cb)
#pragma unroll
        for (int i = 0; i < 16; ++i) acc[cb][i] = 0.f;
#pragma unroll
    for (int s0 = 0; s0 < 8; ++s0) {
        const bf16x8 a = *(const LAS bf16x8*)(Wl + (32 * tb + r32) * 272 + s0 * 32 + hh * 16);
#pragma unroll
        for (int cb = 0; cb < 2; ++cb) { const bf16x8 bb = *(const LAS bf16x8*)(vnT + (64 * chf + 32 * cb + r32) * 272 + s0 * 32 + hh * 16); acc[cb] = MFMA32(a, bb, acc[cb]); }
    }
    LAS float* ot = (LAS float*)(lds + 1024 + 2 * 128 * 272);
#pragma unroll
    for (int cb = 0; cb < 2; ++cb)
#pragma unroll
        for (int r = 0; r < 16; ++r) ot[(32 * tb + crow(r, hh)) * 132 + 64 * chf + 32 * cb + r32] = acc[cb][r];
    __syncthreads();
#pragma unroll
    for (int i = 0; i < 4; ++i) { const int task = tid + 512 * i, tt = task >> 4, c8 = (task & 15) * 8;
        const u32x4 uv = *(const u32x4*)(P + (row0 + tt) * NIN1 + g * 128 + c8);
        const f32x4 m0 = *(const LAS f32x4*)(ot + tt * 132 + c8), m1 = *(const LAS f32x4*)(ot + tt * 132 + c8 + 4);
        const float bs = sgb[g * 128 + tt];
        u32x4 ow;
        ow.x = pk2(bflo(uv.x) * (m0[0] + bs), bfhi(uv.x) * (m0[1] + bs)); ow.y = pk2(bflo(uv.y) * (m0[2] + bs), bfhi(uv.y) * (m0[3] + bs));
        ow.z = pk2(bflo(uv.z) * (m1[0] + bs), bfhi(uv.z) * (m1[1] + bs)); ow.w = pk2(bflo(uv.w) * (m1[2] + bs), bfhi(uv.w) * (m1[3] + bs));
        *(u32x4*)(cat + (row0 + tt) * DM + g * 128 + c8) = ow; }
}

__device__ __forceinline__ void fixup_tile(const float* __restrict__ side, const float* __restrict__ cw, bf16* __restrict__ act, int pm, int tid) {
    for (int idx = tid; idx < 2 * (DFF / 4); idx += 512) {
        const int j = idx / (DFF / 4), ch = (idx % (DFF / 4)) * 4;
        const int colg = (ch >> 7) * 256 + (ch & 127), colu = colg + 128;
        f32x4 yg = *(const f32x4*)(side + (size_t)(pm * 4 + j) * NUP + colg), yu = *(const f32x4*)(side + (size_t)(pm * 4 + j) * NUP + colu);
        if (pm & 7) {
            const f32x4 g255 = *(const f32x4*)(side + (size_t)((pm - 1) * 4 + 3) * NUP + colg), g254 = *(const f32x4*)(side + (size_t)((pm - 1) * 4 + 2) * NUP + colg);
            const f32x4 u255 = *(const f32x4*)(side + (size_t)((pm - 1) * 4 + 3) * NUP + colu), u254 = *(const f32x4*)(side + (size_t)((pm - 1) * 4 + 2) * NUP + colu);
            const f32x4 wg0 = *(const f32x4*)(cw + ch), wg1 = *(const f32x4*)(cw + NUP + ch), wu0 = *(const f32x4*)(cw + DFF + ch), wu1 = *(const f32x4*)(cw + NUP + DFF + ch);
            if (j == 0) { yg += wg1 * g255 + wg0 * g254; yu += wu1 * u255 + wu0 * u254; } else { yg += wg0 * g255; yu += wu0 * u255; }
        }
        u32x2 w; w.x = pk2(pg8::silu_f(yg[0]) * yu[0], pg8::silu_f(yg[1]) * yu[1]); w.y = pk2(pg8::silu_f(yg[2]) * yu[2], pg8::silu_f(yg[3]) * yu[3]);
        *(u32x2*)(act + (size_t)(pm * 256 + j) * DFF + ch) = w;
    }
}

__global__ void __launch_bounds__(512, 2) fwd(Params P) {
    extern __shared__ __attribute__((aligned(16))) unsigned char lds_raw[];
    LAS unsigned char* lds = (LAS unsigned char*)lds_raw;
    cg::grid_group grid = cg::this_grid();
    const int G = gridDim.x, bx = blockIdx.x;
#define PH_IDX const int tid = opaque_tid(), lane = tid & 63, wave = __builtin_amdgcn_readfirstlane(tid >> 6); const int gw = bx * 8 + wave, ngw = G * 8; const size_t gt = (size_t)bx * 512 + tid, gs = (size_t)G * 512; (void)lane; (void)gw; (void)ngw; (void)gt; (void)gs;
    unsigned char* ws = P.ws;
    float* flog = (float*)(ws + WS_FLOG); float* side = (float*)(ws + WS_SIDE);
#define Wt_in(l) ((bf16*)(ws + ((l) == 0 ? WS_WIN0 : WS_WIN1)))
#define Wt_out(l) ((bf16*)(ws + ((l) == 0 ? WS_WOUT0 : WS_WOUT1)))
#define Wt_up(l) ((bf16*)(ws + ((l) == 0 ? WS_WUP0 : WS_WUP1)))
#define Wt_dn(l) ((bf16*)(ws + ((l) == 0 ? WS_WDN0 : WS_WDN1)))
    bf16* Hb = (bf16*)(ws + WS_H); bf16* Pb = (bf16*)(ws + WS_P); bf16* Hb2 = (bf16*)(ws + WS_HB2); float* ssq = (float*)(ws + WS_SSQ);
    float* X = P.out;
    LAS float* hal = (LAS float*)(lds + HAL_OFF);
    if (threadIdx.x < 8) ((volatile LAS unsigned*)(lds + MISC_OFF))[threadIdx.x] = 0u;
    __syncthreads();
    if (blockIdx.x == 0) { for (int i = threadIdx.x; i < XCD_BAR_WORDS; i += 512) __hip_atomic_store((unsigned*)ws + i, 0u, __ATOMIC_RELAXED, __HIP_MEMORY_SCOPE_AGENT); }

    {
        PH_IDX
        LAS float* scr = (LAS float*)(lds + wave * 16384);
        constexpr int I_IN0 = 32 * 192, I_OUT = 32 * 64, I_UP = 32 * 352, I_DN = 88 * 64, I_IN1 = 32 * 160;
        constexpr int NITEMS = I_IN0 + I_IN1 + 2 * (I_OUT + I_UP + I_DN);
#ifndef SKIP_TR
        for (int it = gw; it < NITEMS; it += ngw) {
            int r = it;
            if (r < I_IN0) { transpose_item<0>(P.in[2], DM, NIN0, 192, Wt_in(0), scr, r, lane); continue; } r -= I_IN0;
            if (r < I_IN1) { transpose_item<0>(P.in[10], DM, LDW1, 160, Wt_in(1), scr, r, lane); continue; } r -= I_IN1;
            if (r < I_OUT) { transpose_item<0>(P.in[4], DM, DM, 64, Wt_out(0), scr, r, lane); continue; } r -= I_OUT;
            if (r < I_OUT) { transpose_item<0>(P.in[15], DM, DM, 64, Wt_out(1), scr, r, lane); continue; } r -= I_OUT;
            if (r < I_UP) { transpose_item<1>(P.in[6], DM, NUP, 352, Wt_up(0), scr, r, lane, P.in[5]); continue; } r -= I_UP;
            if (r < I_UP) { transpose_item<1>(P.in[17], DM, NUP, 352, Wt_up(1), scr, r, lane, P.in[16]); continue; } r -= I_UP;
            if (r < I_DN) { transpose_item<0>(P.in[8], DFF, DM, 64, Wt_dn(0), scr, r, lane); continue; } r -= I_DN;
            transpose_item<0>(P.in[19], DFF, DM, 64, Wt_dn(1), scr, r, lane);
        }
#endif
        rms_rows<0>(P.in[0], P.in[1], Hb, nullptr, nullptr, nullptr, gw, ngw, lane);
    }
    grid.sync();
#ifdef USE_CG_SYNC
#define GSYNC() grid.sync()
#elif defined(USE_CTR_SYNC)
    unsigned bar_round = 0;
#define GSYNC() do { ++bar_round; ctr_barrier((unsigned*)ws + 64, bar_round * (unsigned)G); } while (0)
#else
#ifdef XB_FENCE_ALL
#define GSYNC() xcd_barrier(xbar)
#else
#define GSYNC() xcd_barrier(xbar)
#endif
#endif
    const XcdBarrier xbar = xcd_barrier_post((unsigned*)ws, (volatile LAS unsigned*)(lds + MISC_OFF));

    for (int layer = 0; layer < 2; ++layer) {
        {
            const int N = layer == 0 ? NIN0 : NIN1;
            pg8::Gemm g{Hb, Wt_in(layer), M, N, DM}; pg8::StaticOrder S; S.init(M, N, G, bx);
            pg8::EpiStore E{Pb, N, layer == 0 ? 0 : 8};
#ifndef SKIP_IN
            pg8::gemm_phase<pg8::EpiStore, pg8::StaticOrder, true, true>(lds, g, S, E);
#endif
        }
        GSYNC();
#ifdef PROBE_SYNC
        for (int i = 0; i < 10; ++i) GSYNC();
#endif
#ifdef PROBE_MIX
        for (int rep = 0; rep < 2; ++rep)
#endif
        if (layer == 0) {
            PH_IDX
            for (int pi = bx; pi < 256; pi += G) { const int bh = pi >> 2, s = pi & 3;
#ifndef SKIP_ATT0
                attn_item<0>(lds, Pb, NIN0, 0, 1024, 2048, Hb, 0, bh >> 3, bh & 7, 7 - s, nullptr, 0.f);
                attn_item<0>(lds, Pb, NIN0, 0, 1024, 2048, Hb, 0, bh >> 3, bh & 7, s, nullptr, 0.f);
#endif
            }
#ifndef SKIP_SC
            shortconv_phase(Pb, P.in[3], Hb, gt, gs);
#endif
        } else {
            for (int pi = bx; pi < 256; pi += G) { const int bh = pi >> 2, s = pi & 3; const float bfh = P.in[11][bh & 7];
#ifndef SKIP_ATT1
                attn_item<1>(lds, Pb, NIN1, 2048, 3072, 4096, Hb, 1024, bh >> 3, bh & 7, 7 - s, flog, bfh);
                attn_item<1>(lds, Pb, NIN1, 2048, 3072, 4096, Hb, 1024, bh >> 3, bh & 7, s, flog, bfh);
#endif
            }
#ifndef SKIP_GMLP
            for (int pr = bx; pr < 256; pr += G) { const int bn = pr >> 1, gh = pr & 1;
                gmlp_stats(lds, Pb, bn >> 4, bn & 15);
                for (int g4 = 0; g4 < 4; ++g4) gmlp_item(lds, Pb, P.in[12], P.in[13], P.in[14], Hb, bn >> 4, bn & 15, 4 * gh + g4); }
#endif
        }
        GSYNC();
        {
            pg8::Gemm g{Hb, Wt_out(layer), M, DM, DM}; pg8::StaticOrder S; S.init(M, DM, G, bx);
            if (layer == 0) { pg8::EpiResidT<true, false> E{P.in[0], X, DM, Hb2, ssq, nullptr};
                pg8::gemm_phase<pg8::EpiResidT<true, false>, pg8::StaticOrder, true, true>(lds, g, S, E); }
            else { pg8::EpiResidT<true, false, true> E{nullptr, X, DM, Hb2, ssq, Hb2};
                pg8::gemm_phase<pg8::EpiResidT<true, false, true>, pg8::StaticOrder, true, true>(lds, g, S, E); }
        }
        GSYNC();
#ifdef PROBE_UP
        for (int rep = 0; rep < 2; ++rep)
#endif
        {
            pg8::Gemm g{Hb2, Wt_up(layer), M, NUP, DM}; pg8::StaticOrder S; S.init(M, NUP, G, bx);
            LAS float* rsl = (LAS float*)(lds + MISC_OFF + 64);
            pg8::Unit u0; int pm0 = -1;
            if (S.next(0, u0)) { pm0 = u0.pm;
                PH_IDX
                if (tid < 256) { const float* sp = ssq + (size_t)(pm0 * 256 + tid) * 32; float t = 0.f;
#pragma unroll
                    for (int j = 0; j < 8; ++j) { const f32x4 a = *(const f32x4*)(sp + 4 * j); t += (a[0] + a[1]) + (a[2] + a[3]); }
                    rsl[tid] = 1.0f / sqrtf(t * (1.0f / 2048.0f) + 1e-6f); }
                __syncthreads(); }
            pg8::EpiUpConv E{Pb, (layer == 0 ? P.in[7] : P.in[18]), side, hal, ssq, rsl, (LAS float*)(lds + MISC_OFF + 1152), pm0};
#ifndef SKIP_UP
            pg8::gemm_phase<pg8::EpiUpConv, pg8::StaticOrder, true, true>(lds, g, S, E);
#endif
        }
        GSYNC();
        {
            pg8::Gemm g{Pb, Wt_dn(layer), M, DM, DFF}; pg8::StaticOrder S; S.init(M, DM, G, bx);
            {
                PH_IDX pg8::Unit fu;
                for (int i = 0; S.next(i, fu); ++i) fixup_tile(side, (layer == 0 ? P.in[7] : P.in[18]), Pb, fu.pm, tid);
                asm volatile("s_waitcnt vmcnt(0)" ::: "memory"); __syncthreads();
            }
            pg8::EpiResidT<true, false, true> E{nullptr, X, DM, Hb2, ssq, Hb2};
            pg8::gemm_phase<pg8::EpiResidT<true, false, true>, pg8::StaticOrder, true, true>(lds, g, S, E);
        }
        GSYNC();
        if (layer == 0) {
            PH_IDX
            LAS float* WfT = (LAS float*)lds;
            for (int idx = tid; idx < DM * 8; idx += 512) { const int k = idx >> 3, j = idx & 7; WfT[j * DM + k] = P.in[10][(size_t)k * LDW1 + NIN1 + j]; }
            __syncthreads();
#ifndef SKIP_RMS1
            rms1_rows_bf16(Hb2, ssq, P.in[9], Hb, WfT, flog, gw, ngw, lane);
#endif
            __syncthreads();
            GSYNC();
        }
    }
    {
        PH_IDX
        const float* gf = P.in[20];
        f32x4 gv[8];
#pragma unroll
        for (int j = 0; j < 8; ++j) gv[j] = ((const f32x4*)gf)[64 * j + lane];
        for (int m = gw; m < M; m += ngw) {
            const float part = (lane < 32) ? ssq[(size_t)m * 32 + lane] : 0.f;
            const float rs = 1.0f / sqrtf(wave_sum(part) * (1.0f / DM) + EPS);
            const u32x2* xr = (const u32x2*)(Hb2 + (size_t)m * DM) + lane;
            f32x4* o = (f32x4*)(X + (size_t)m * DM) + lane;
            u32x2 xv[8];
#pragma unroll
            for (int j = 0; j < 8; ++j) xv[j] = xr[64 * j];
#pragma unroll
            for (int j = 0; j < 8; ++j) { f32x4 v; v.x = bflo(xv[j].x); v.y = bfhi(xv[j].x); v.z = bflo(xv[j].y); v.w = bfhi(xv[j].y); o[64 * j] = v * rs * gv[j]; }
        }
    }
}

extern "C" void kernel_launch(void* const* d_in, const int* in_sizes, int n_in, void* d_out, int out_size, void* d_ws, size_t ws_size, hipStream_t stream) {
    static int grid = 0;
    if (grid == 0) {
        int dev = 0, cus = 0, per_cu = 0;
        (void)hipGetDevice(&dev);
        (void)hipDeviceGetAttribute(&cus, hipDeviceAttributeMultiprocessorCount, dev);
        (void)hipFuncSetAttribute((const void*)fwd, hipFuncAttributeMaxDynamicSharedMemorySize, LDS_BYTES);
        (void)hipOccupancyMaxActiveBlocksPerMultiprocessor(&per_cu, (const void*)fwd, 512, LDS_BYTES);
        (void)hipGetLastError();
        if (cus <= 0) cus = 256;
        grid = cus;
        if (n_in != 21 || ws_size < WS_END) fprintf(stderr, "kernel_launch: unexpected n_in %d / ws %zu\n", n_in, ws_size);
    }
    Params p{};
    for (int i = 0; i < 21 && i < n_in; ++i) p.in[i] = (const float*)d_in[i];
    p.out = (float*)d_out; p.ws = (unsigned char*)d_ws;
    void* args[] = {&p};
    hipError_t e = hipLaunchCooperativeKernel((const void*)fwd, dim3(grid), dim3(512), args, LDS_BYTES, stream);
    if (e != hipSuccess) fprintf(stderr, "cooperative launch failed: %s (grid %d)\n", hipGetErrorString(e), grid);
}
```

```cpp
#include <hip/hip_runtime.h>
#include <hip/hip_cooperative_groups.h>
#include <cstdio>
#include <cstdint>
namespace cg = cooperative_groups;
__device__ __forceinline__ int opaque_tid() { int t = threadIdx.x; asm volatile("" : "+v"(t)); return t; }

namespace pg8 {
#define PG8_LAS __attribute__((address_space(3)))
typedef unsigned short bf16_t;
typedef short bf16x8 __attribute__((ext_vector_type(8)));
typedef float f32x4 __attribute__((ext_vector_type(4)));
typedef float f32x2 __attribute__((ext_vector_type(2)));
typedef unsigned u32x4 __attribute__((ext_vector_type(4)));
typedef unsigned u32x2 __attribute__((ext_vector_type(2)));
constexpr int BM = 256, BK = 64, HALF = 128, HTB = HALF * BK * 2, STAGE_BYTES = 8 * HTB, NXCD = 8, WGM = 8;

__host__ __device__ __forceinline__ int lds_byte(int r, int c) { const int st = (r >> 4) * 2 + (c >> 5), rr = r & 15, cc = c & 31, ob = rr * 64 + cc * 2; return st * 1024 + (ob ^ (((ob >> 9) & 1) << 5)); }
__host__ __device__ __forceinline__ void stage_rc(int b, int& R, int& C) { const int st = b / 1024, sb = b % 1024, swz = sb ^ (((sb >> 9) & 1) << 5); R = (st >> 1) * 16 + swz / 64; C = (st & 1) * 32 + (swz % 64) / 2; }
__host__ __device__ __forceinline__ int perm32(int rho) { const int n = rho >> 4, i = rho & 15; return 8 * (i >> 2) + 4 * n + (i & 3); }

struct Unit { int pm, pn; };
struct Gemm { const bf16_t* A; const bf16_t* Bt; int M, N, K; };

struct StaticOrder {
    int nM, nN, nwg, G, c;
    __host__ __device__ void init(int M, int N, int G_, int c_) { nM = M / BM; nN = N / BM; nwg = nM * nN; G = G_; c = c_; }
    __host__ __device__ bool next(int i, Unit& u) const {
        const long L = (long)i * G + c; if (L >= nwg) return false;
        int wgid = (int)L; { const int q = nwg / NXCD, r = nwg % NXCD, xcd = wgid % NXCD, off = wgid / NXCD; wgid = (xcd < r ? xcd * (q + 1) : r * (q + 1) + (xcd - r) * q) + off; }
        const int nig = WGM * nN, gid = wgid / nig, fm = gid * WGM, gsz = (nM - fm) < WGM ? (nM - fm) : WGM;
        u.pm = fm + ((wgid % nig) % gsz); u.pn = (wgid % nig) / gsz; return true;
    }
    __device__ __forceinline__ void a_ready(const Unit&) const {}
    __device__ __forceinline__ void done(const Unit&) const {}
};

__device__ __forceinline__ unsigned cvt_pk_bf16(float lo, float hi) { unsigned r; asm volatile("v_cvt_pk_bf16_f32 %0, %1, %2" : "=v"(r) : "v"(lo), "v"(hi)); return r; }
__device__ __forceinline__ float gelu_tanh(float x) { const float u2 = 1.5957691216057308f * (x + 0.044715f * x * x * x); return x * __builtin_amdgcn_rcpf(1.0f + __expf(-u2)); }
__device__ __forceinline__ float silu_f(float x) { return x * __builtin_amdgcn_rcpf(1.0f + __expf(-x)); }

struct EpiStore {
    static constexpr bool PERM = true, AFTER_DRAIN = false, INIT = false, HOOK = false, PERMA = false;
    bf16_t* O; int ldc; int gelu_tiles;
    __device__ __forceinline__ void operator()(const f32x4 (&acc)[2][2][4][2], const Unit& u, int wr, int wc, int fr, int fq) const {
        const int row0 = u.pm * BM + wr * 64 + fr; const int col0 = u.pn * BM + wc * 32 + 8 * fq;
        const bool g = u.pn < gelu_tiles;
#pragma unroll
        for (int ai = 0; ai < 2; ++ai)
#pragma unroll
            for (int m = 0; m < 4; ++m) { bf16_t* rowp = O + (size_t)(row0 + ai * HALF + m * 16) * ldc + col0;
#pragma unroll
                for (int bj = 0; bj < 2; ++bj) { f32x4 v0 = acc[ai][bj][m][0], v1 = acc[ai][bj][m][1];
                    if (g) {
#pragma unroll
                        for (int e = 0; e < 4; ++e) { v0[e] = gelu_tanh(v0[e]); v1[e] = gelu_tanh(v1[e]); } }
                    u32x4 w; w.x = cvt_pk_bf16(v0[0], v0[1]); w.y = cvt_pk_bf16(v0[2], v0[3]); w.z = cvt_pk_bf16(v1[0], v1[1]); w.w = cvt_pk_bf16(v1[2], v1[3]);
                    *(u32x4*)(rowp + bj * HALF) = w; }
                if (m & 1) asm volatile("" ::: "memory"); }
    }
};
template <bool NOUT, bool WF32 = true, bool RB16 = false> struct EpiResidT {
    static constexpr bool PERM = false, AFTER_DRAIN = false, INIT = true, HOOK = false, PERMA = false;
    const float* base; float* out; int ldc; bf16_t* xb; float* ssq; const bf16_t* xb16;
    __device__ __forceinline__ void init(f32x4 (&acc)[2][2][4][2], const Unit& u, int wr, int wc, int fr, int fq) const {
        const int col0 = u.pn * BM + wc * 32 + 4 * fq;
#pragma unroll
        for (int ai = 0; ai < 2; ++ai)
#pragma unroll
            for (int m = 0; m < 4; ++m) { const size_t off = (size_t)(u.pm * BM + ai * HALF + wr * 64 + m * 16 + fr) * ldc + col0;
#pragma unroll
                for (int bj = 0; bj < 2; ++bj)
#pragma unroll
                    for (int n = 0; n < 2; ++n) {
                        if (RB16) { const u32x2 w = *(const u32x2*)(xb16 + off + bj * HALF + n * 16); acc[ai][bj][m][n] = (f32x4){__uint_as_float(w.x << 16), __uint_as_float(w.x & 0xffff0000u), __uint_as_float(w.y << 16), __uint_as_float(w.y & 0xffff0000u)}; }
                        else acc[ai][bj][m][n] = *(const f32x4*)(base + off + bj * HALF + n * 16); } }
    }
    __device__ __forceinline__ void operator()(const f32x4 (&acc)[2][2][4][2], const Unit& u, int wr, int wc, int fr, int fq) const {
        const int col0 = u.pn * BM + wc * 32 + 4 * fq;
#pragma unroll
        for (int ai = 0; ai < 2; ++ai)
#pragma unroll
            for (int m = 0; m < 4; ++m) { const int row = u.pm * BM + ai * HALF + wr * 64 + m * 16 + fr; const size_t off = (size_t)row * ldc + col0;
                float sq = 0.f;
#pragma unroll
                for (int bj = 0; bj < 2; ++bj)
#pragma unroll
                    for (int n = 0; n < 2; ++n) { const f32x4 o = acc[ai][bj][m][n]; if (WF32) *(f32x4*)(out + off + bj * HALF + n * 16) = o;
                        if (NOUT) { u32x2 w; w.x = cvt_pk_bf16(o[0], o[1]); w.y = cvt_pk_bf16(o[2], o[3]); *(u32x2*)(xb + off + bj * HALF + n * 16) = w; sq += (o[0] * o[0] + o[1] * o[1]) + (o[2] * o[2] + o[3] * o[3]); } }
                if (NOUT) { sq += __shfl_xor(sq, 16); sq += __shfl_xor(sq, 32); if (fq == 0) ssq[(size_t)row * 32 + u.pn * 4 + wc] = sq; }
                asm volatile("" ::: "memory"); }
    }
};
constexpr int NUPC = 11264, DFFC = 5632;
struct EpiUpConv {
    static constexpr bool PERM = true, AFTER_DRAIN = false, INIT = false, HOOK = true, PERMA = true;
    bf16_t* act; const float* cw; float* side; PG8_LAS float* hal; const float* ssq; PG8_LAS float* rs; PG8_LAS float* cwl2; int pm0;
    __device__ __forceinline__ void begin_unit(const Unit& u, int ui, int wid, int lane) const {
        if (wid < 3) { const float* src = cw + wid * NUPC + (lane >> 5) * DFFC + u.pn * HALF + (lane & 31) * 4;
            __builtin_amdgcn_global_load_lds((const unsigned*)src, (PG8_LAS unsigned*)(cwl2 + (ui & 1) * 768 + wid * 256), 16, 0, 0); }
    }
    __device__ __forceinline__ void operator()(f32x4 (&acc)[2][2][4][2], const Unit& u, int wr, int wc, int fr, int fq, int ui) const {
        const PG8_LAS float* cwl = cwl2 + (ui & 1) * 768;
        if (u.pm != pm0) {
            int l2 = fq * 16 + fr; asm volatile("" : "+v"(l2));
            const int rl = (wr * 4 + wc) * 32 + (l2 & 31), hf = l2 >> 5;
            const float* sp = ssq + (size_t)(u.pm * BM + rl) * 32 + hf * 16;
            const f32x4 a0 = *(const f32x4*)sp, a1 = *(const f32x4*)(sp + 4), a2 = *(const f32x4*)(sp + 8), a3 = *(const f32x4*)(sp + 12);
            float t = ((a0[0] + a0[1]) + (a0[2] + a0[3])) + ((a1[0] + a1[1]) + (a1[2] + a1[3])) + ((a2[0] + a2[1]) + (a2[2] + a2[3])) + ((a3[0] + a3[1]) + (a3[2] + a3[3]));
            t += __shfl_xor(t, 32);
            asm volatile("s_waitcnt lgkmcnt(0)" ::: "memory"); __builtin_amdgcn_s_barrier(); asm volatile("" ::: "memory");
            if (hf == 0) rs[rl] = 1.0f / sqrtf(t * (1.0f / 2048.0f) + 1e-6f);
            asm volatile("s_waitcnt lgkmcnt(0)" ::: "memory"); __builtin_amdgcn_s_barrier(); asm volatile("" ::: "memory");
        }
        {
            int frr = fr; asm volatile("" : "+v"(frr));
            const PG8_LAS float* rp = rs + wr * 64 + 4 * frr;
#pragma unroll
            for (int ai = 0; ai < 2; ++ai)
#pragma unroll
                for (int m = 0; m < 4; ++m) { const float r = rp[ai * HALF + m];
#pragma unroll
                    for (int bj = 0; bj < 2; ++bj)
#pragma unroll
                        for (int n = 0; n < 2; ++n) acc[ai][bj][m][n] = acc[ai][bj][m][n] * r; }
        }
        int cl = wc * 32 + 8 * fq; asm volatile("" : "+v"(cl));
        const PG8_LAS unsigned char* halr = (const PG8_LAS unsigned char*)hal - 2048 + wr * 2048 + cl * 4;
        if (fr == 15) {
            PG8_LAS unsigned char* halw = (PG8_LAS unsigned char*)hal + wr * 2048 + cl * 4;
#pragma unroll
            for (int ai = 0; ai < 2; ++ai) { const int s = 2 * ai + wr;
#pragma unroll
                for (int j = 0; j < 2; ++j)
#pragma unroll
                    for (int bj = 0; bj < 2; ++bj)
#pragma unroll
                        for (int n = 0; n < 2; ++n) { const f32x4 v = acc[ai][bj][2 + j][n];
                            *(PG8_LAS f32x4*)(halw + ai * 4096 + j * 1024 + bj * 512 + n * 16) = v;
                            if (s == 3) *(f32x4*)(side + ((size_t)(u.pm * 4 + 2 + j) * NUPC + u.pn * BM + bj * HALF + cl + 4 * n)) = v; } }
        }
        asm volatile("s_waitcnt lgkmcnt(0)" ::: "memory"); __builtin_amdgcn_s_barrier(); asm volatile("" ::: "memory");
        const int ch0 = u.pn * HALF + cl;
#pragma unroll
        for (int ai = 0; ai < 2; ++ai) { const int s = 2 * ai + wr;
#pragma unroll
            for (int n = 0; n < 2; ++n) {
                unsigned wv[4][2];
#pragma unroll
                for (int ep = 0; ep < 2; ++ep) {
                    float yv[2][4][2];
#pragma unroll
                    for (int bj = 0; bj < 2; ++bj) {
                        const PG8_LAS float* wl = cwl + bj * HALF + cl + 4 * n + 2 * ep;
                        const f32x2 w0 = *(const PG8_LAS f32x2*)(wl), w1 = *(const PG8_LAS f32x2*)(wl + 256), w2 = *(const PG8_LAS f32x2*)(wl + 512);
                        f32x2 H1 = {0.f, 0.f}, H2 = {0.f, 0.f};
                        if (s > 0 && fr == 0) { H1 = *(const PG8_LAS f32x2*)(halr + ai * 4096 + 1024 + bj * 512 + n * 16 + ep * 8); H2 = *(const PG8_LAS f32x2*)(halr + ai * 4096 + bj * 512 + n * 16 + ep * 8); }
#pragma unroll
                        for (int e = 0; e < 2; ++e) {
                            const float a0 = acc[ai][bj][0][n][2 * ep + e], a1 = acc[ai][bj][1][n][2 * ep + e], a2 = acc[ai][bj][2][n][2 * ep + e], a3 = acc[ai][bj][3][n][2 * ep + e];
                            float y0 = w2[e] * a0 + w1[e] * H1[e] + w0[e] * H2[e];
                            float y1 = w2[e] * a1 + w1[e] * a0 + w0[e] * H1[e];
                            const float y2 = w2[e] * a2 + w1[e] * a1 + w0[e] * a0;
                            const float y3 = w2[e] * a3 + w1[e] * a2 + w0[e] * a1;
                            asm volatile("s_nop 1\n\t"
                                         "v_fmac_f32_dpp %0, %3, %4 row_shr:1 row_mask:0xf bank_mask:0xf bound_ctrl:0\n\t"
                                         "v_fmac_f32_dpp %0, %2, %5 row_shr:1 row_mask:0xf bank_mask:0xf bound_ctrl:0\n\t"
                                         "v_fmac_f32_dpp %1, %3, %5 row_shr:1 row_mask:0xf bank_mask:0xf bound_ctrl:0"
                                         : "+v"(y0), "+v"(y1)
                                         : "v"(a2), "v"(a3), "v"(w1[e]), "v"(w0[e]));
                            yv[bj][0][e] = y0; yv[bj][1][e] = y1; yv[bj][2][e] = y2; yv[bj][3][e] = y3;
                        }
                    }
#pragma unroll
                    for (int m = 0; m < 4; ++m) {
                        wv[m][ep] = cvt_pk_bf16(silu_f(yv[0][m][0]) * yv[1][m][0], silu_f(yv[0][m][1]) * yv[1][m][1]);
                        if (m < 2 && s == 0 && fr == 0) {
                            *(f32x2*)(side + ((size_t)(u.pm * 4 + m) * NUPC + u.pn * BM + cl + 4 * n + 2 * ep)) = (f32x2){yv[0][m][0], yv[0][m][1]};
                            *(f32x2*)(side + ((size_t)(u.pm * 4 + m) * NUPC + u.pn * BM + HALF + cl + 4 * n + 2 * ep)) = (f32x2){yv[1][m][0], yv[1][m][1]}; }
                    }
                    asm volatile("" ::: "memory"); __builtin_amdgcn_sched_barrier(0);
                }
#pragma unroll
                for (int m = 0; m < 4; ++m) {
                    const int row = u.pm * BM + ai * HALF + wr * 64 + 4 * fr + m;
                    u32x2 w; w.x = wv[m][0]; w.y = wv[m][1];
                    *(u32x2*)(act + (size_t)row * DFFC + ch0 + 4 * n) = w;
                }
                asm volatile("" ::: "memory"); __builtin_amdgcn_sched_barrier(0);
            }
        }
    }
};

template <class Epi, class Sched, bool ALIGN_EPI = false, bool SP2 = false>
__device__ __forceinline__ void gemm_phase(PG8_LAS unsigned char* lds, const Gemm g, const Sched& S, const Epi& E) {
    const int tid = opaque_tid(), wid = __builtin_amdgcn_readfirstlane(tid >> 6), lane = tid & 63, wr = wid >> 2, wc = wid & 3, fr = lane & 15, fq = lane >> 4;
    const int K = g.K, nt = K / BK;
    unsigned voffA[2], voffB[2];
#pragma unroll
    for (int i = 0; i < 2; ++i) { int R, C; stage_rc(tid * 16 + i * 8192, R, C); const int Rb = Epi::PERM ? ((R & ~31) + perm32(R & 31)) : R;
        const int Ra = Epi::PERMA ? ((R & ~63) + 4 * (R & 15) + ((R >> 4) & 3)) : R;
        voffA[i] = (unsigned)(Ra * K + C) * 2u; voffB[i] = (unsigned)(Rb * K + C) * 2u; }
    const size_t kstep = (size_t)(BK * 2);
    const size_t hstep = (size_t)HALF * K * 2;
    const size_t tstep = 2 * hstep;
    const unsigned ldsw = (unsigned)wid * 1024u;
    const int aoff = lds_byte(wr * 64 + fr, fq * 8), boff = lds_byte(wc * 32 + fr, fq * 8);
#define PG8_SA(b, h) (((b) * 2 + (h)) * HTB)
#define PG8_SB(b, h) ((4 + (b) * 2 + (h)) * HTB)
#define PG8_STAGE(bufoff, gbase, voff) do { _Pragma("unroll") for (int _i = 0; _i < 2; ++_i) \
        __builtin_amdgcn_global_load_lds((const unsigned*)((const char*)(gbase) + (voff)[_i]), (PG8_LAS unsigned*)(lds + (bufoff) + ldsw + _i * 8192), 16, 0, 0); } while (0)
#define PG8_LDA(dst, b, h) do { _Pragma("unroll") for (int m = 0; m < 4; ++m) _Pragma("unroll") for (int k = 0; k < 2; ++k) dst[m][k] = *(const PG8_LAS bf16x8*)(lds + PG8_SA(b, h) + aoff + m * 2048 + k * 1024); } while (0)
#define PG8_LDB(dst, b, h) do { _Pragma("unroll") for (int n = 0; n < 2; ++n) _Pragma("unroll") for (int k = 0; k < 2; ++k) dst[n][k] = *(const PG8_LAS bf16x8*)(lds + PG8_SB(b, h) + boff + n * 2048 + k * 1024); } while (0)
#define PG8_MMA(ai, bj, At, Bt) do { __builtin_amdgcn_s_setprio(3); _Pragma("unroll") for (int m = 0; m < 4; ++m) _Pragma("unroll") for (int n = 0; n < 2; ++n) _Pragma("unroll") for (int k = 0; k < 2; ++k) \
        acc[ai][bj][m][n] = __builtin_amdgcn_mfma_f32_16x16x32_bf16(Bt[n][k], At[m][k], acc[ai][bj][m][n], 0, 0, 0); __builtin_amdgcn_s_setprio(0); } while (0)
#define PG8_WAIT_V(n) asm volatile("s_waitcnt vmcnt(" #n ")" ::: "memory")
#define PG8_WAIT_L(n) asm volatile("s_waitcnt lgkmcnt(" #n ")" ::: "memory")
#define PG8_BAR __builtin_amdgcn_s_barrier()
#define PG8_SCHED __builtin_amdgcn_sched_barrier(0)
    Unit cur, nxt; int ui = 0;
    if (!S.next(0, cur)) return;
    f32x4 acc[2][2][4][2];
    if constexpr (Epi::HOOK) E.begin_unit(cur, 0, wid, lane);
    if constexpr (Epi::INIT) E.init(acc, cur, wr, wc, fr, fq);
    else {
#pragma unroll
    for (int a = 0; a < 2; ++a)
#pragma unroll
        for (int b = 0; b < 2; ++b)
#pragma unroll
            for (int m = 0; m < 4; ++m)
#pragma unroll
                for (int n = 0; n < 2; ++n) acc[a][b][m][n] = (f32x4){0.f, 0.f, 0.f, 0.f};
    }
    bf16x8 At[4][2], B0[2][2], B1[2][2];
    const char* cA = (const char*)g.A + (size_t)cur.pm * tstep; const char* cB = (const char*)g.Bt + (size_t)cur.pn * tstep;
    S.a_ready(cur);
    if constexpr (SP2) {
        PG8_STAGE(PG8_SB(0, 0), cB, voffB); PG8_STAGE(PG8_SB(0, 1), cB + hstep, voffB); PG8_STAGE(PG8_SA(0, 0), cA, voffA); PG8_STAGE(PG8_SA(0, 1), cA + hstep, voffA);
        if (wr == 1) PG8_BAR;
        PG8_WAIT_V(2); PG8_BAR;
        PG8_STAGE(PG8_SB(1, 0), cB + kstep, voffB); PG8_STAGE(PG8_SA(1, 0), cA + kstep, voffA); PG8_STAGE(PG8_SB(1, 1), cB + hstep + kstep, voffB);
        PG8_WAIT_V(6); PG8_BAR;
    } else {
        PG8_STAGE(PG8_SB(0, 0), cB, voffB); PG8_STAGE(PG8_SA(0, 0), cA, voffA); PG8_STAGE(PG8_SB(0, 1), cB + hstep, voffB); PG8_STAGE(PG8_SA(0, 1), cA + hstep, voffA);
        if (wr == 1) PG8_BAR;
        PG8_WAIT_V(4); PG8_BAR;
        PG8_STAGE(PG8_SB(1, 0), cB + kstep, voffB); PG8_STAGE(PG8_SA(1, 0), cA + kstep, voffA); PG8_STAGE(PG8_SB(1, 1), cB + hstep + kstep, voffB);
        PG8_WAIT_V(6); PG8_BAR;
    }
    for (;;) {
        const bool has_next = S.next(ui + 1, nxt);
        const char* nA = has_next ? (const char*)g.A + (size_t)nxt.pm * tstep : cA; const char* nB = has_next ? (const char*)g.Bt + (size_t)nxt.pn * tstep : cB;
        for (int t = 0; t < nt; t += 2) {
            const bool last = (t == nt - 2);
            const char* a1 = cA + (size_t)(t + 1) * kstep;
            const char* a2 = last ? nA : cA + (size_t)(t + 2) * kstep; const char* b2 = last ? nB : cB + (size_t)(t + 2) * kstep;
            const char* a3 = a2 + kstep; const char* b3 = b2 + kstep;
            if (last && has_next) S.a_ready(nxt);
            if constexpr (SP2) {
            PG8_LDB(B0, 0, 0); PG8_LDB(B1, 0, 1); PG8_SCHED; PG8_LDA(At, 0, 0); PG8_STAGE(PG8_SA(1, 1), a1 + hstep, voffA);
            PG8_WAIT_V(8); PG8_WAIT_L(0); PG8_BAR; PG8_MMA(0, 0, At, B0); PG8_MMA(0, 1, At, B1); PG8_BAR; PG8_SCHED;
            PG8_LDA(At, 0, 1); PG8_STAGE(PG8_SB(0, 0), b2, voffB); PG8_STAGE(PG8_SB(0, 1), b2 + hstep, voffB); PG8_STAGE(PG8_SA(0, 0), a2, voffA);
            PG8_WAIT_V(8); PG8_WAIT_L(0); PG8_BAR; PG8_MMA(1, 0, At, B0); PG8_MMA(1, 1, At, B1); PG8_BAR; PG8_SCHED;
            PG8_LDB(B0, 1, 0); PG8_LDB(B1, 1, 1); PG8_SCHED; PG8_LDA(At, 1, 0); PG8_STAGE(PG8_SA(0, 1), a2 + hstep, voffA);
            PG8_WAIT_V(8); PG8_WAIT_L(0); PG8_BAR; PG8_MMA(0, 0, At, B0); PG8_MMA(0, 1, At, B1); PG8_BAR; PG8_SCHED;
            PG8_LDA(At, 1, 1); PG8_STAGE(PG8_SB(1, 0), b3, voffB); PG8_STAGE(PG8_SB(1, 1), b3 + hstep, voffB); PG8_STAGE(PG8_SA(1, 0), a3, voffA);
            PG8_WAIT_V(8); PG8_WAIT_L(0); PG8_BAR; PG8_MMA(1, 0, At, B0); PG8_MMA(1, 1, At, B1); PG8_BAR; PG8_SCHED;
            } else {
            PG8_LDB(B0, 0, 0); PG8_SCHED; PG8_LDA(At, 0, 0); PG8_STAGE(PG8_SA(1, 1), a1 + hstep, voffA);
            PG8_WAIT_L(8); PG8_BAR; PG8_WAIT_L(0); PG8_MMA(0, 0, At, B0); PG8_BAR; PG8_SCHED;
            PG8_LDB(B1, 0, 1); PG8_STAGE(PG8_SB(0, 0), b2, voffB);
            PG8_BAR; PG8_WAIT_L(0); PG8_MMA(0, 1, At, B1); PG8_BAR;
            PG8_LDA(At, 0, 1); PG8_STAGE(PG8_SA(0, 0), a2, voffA);
            PG8_BAR; PG8_WAIT_L(0); PG8_MMA(1, 0, At, B0); PG8_BAR; PG8_SCHED;
            PG8_STAGE(PG8_SB(0, 1), b2 + hstep, voffB);
            PG8_WAIT_V(6); PG8_BAR; PG8_MMA(1, 1, At, B1); PG8_BAR;
            PG8_LDB(B0, 1, 0); PG8_SCHED; PG8_LDA(At, 1, 0); PG8_STAGE(PG8_SA(0, 1), a2 + hstep, voffA);
            PG8_WAIT_L(8); PG8_BAR; PG8_WAIT_L(0); PG8_MMA(0, 0, At, B0); PG8_BAR; PG8_SCHED;
            PG8_LDB(B1, 1, 1); PG8_STAGE(PG8_SB(1, 0), b3, voffB);
            PG8_BAR; PG8_WAIT_L(0); PG8_MMA(0, 1, At, B1); PG8_BAR;
            PG8_LDA(At, 1, 1); PG8_STAGE(PG8_SA(1, 0), a3, voffA);
            PG8_BAR; PG8_WAIT_L(0); PG8_MMA(1, 0, At, B0); PG8_BAR; PG8_SCHED;
            PG8_STAGE(PG8_SB(1, 1), b3 + hstep, voffB);
            PG8_WAIT_V(6); PG8_BAR; PG8_MMA(1, 1, At, B1); PG8_BAR;
            }
        }
        if constexpr (ALIGN_EPI) { if (wr == 0) PG8_BAR; }
        if constexpr (!Epi::AFTER_DRAIN) { if constexpr (Epi::HOOK) E(acc, cur, wr, wc, fr, fq, ui); else E(acc, cur, wr, wc, fr, fq); S.done(cur); }
        if (!has_next) break;
        if constexpr (Epi::HOOK) E.begin_unit(nxt, ui + 1, wid, lane);
        if constexpr (Epi::INIT) E.init(acc, nxt, wr, wc, fr, fq);
        else {
#pragma unroll
        for (int a = 0; a < 2; ++a)
#pragma unroll
            for (int b = 0; b < 2; ++b)
#pragma unroll
                for (int m = 0; m < 4; ++m)
#pragma unroll
                    for (int n = 0; n < 2; ++n) acc[a][b][m][n] = (f32x4){0.f, 0.f, 0.f, 0.f};
        }
        cur = nxt; cA = nA; cB = nB; ++ui;
        if constexpr (ALIGN_EPI) { if (wr == 1) PG8_BAR; }
    }
    PG8_WAIT_V(0);
    if constexpr (!ALIGN_EPI) { if (wr == 0) PG8_BAR; }
    PG8_BAR;
#undef PG8_SA
#undef PG8_SB
#undef PG8_STAGE
#undef PG8_LDA
#undef PG8_LDB
#undef PG8_MMA
#undef PG8_WAIT_V
#undef PG8_WAIT_L
#undef PG8_BAR
#undef PG8_SCHED
}
}

#define LAS __attribute__((address_space(3)))
typedef unsigned short bf16;
typedef short bf16x8 __attribute__((ext_vector_type(8)));
typedef float f32x4 __attribute__((ext_vector_type(4)));
typedef float f32x2 __attribute__((ext_vector_type(2)));
typedef float f32x16 __attribute__((ext_vector_type(16)));
typedef unsigned u32x4 __attribute__((ext_vector_type(4)));
typedef unsigned u32x2 __attribute__((ext_vector_type(2)));
typedef __bf16 bf16x2_t __attribute__((ext_vector_type(2)));

constexpr int SEQ = 2048, BATCH = 8, DM = 2048, M = BATCH * SEQ, DFF = 5632, NUP = 2 * DFF, NIN0 = 6144, NIN1 = 5120, LDW1 = 5128;
constexpr float EPS = 1e-6f;
constexpr float ATT_SCALE = 0.08838834764831845f;
constexpr size_t MiB = 1u << 20;
constexpr size_t WS_FLOG = 1 * MiB, WS_SIDE = 2 * MiB;
constexpr size_t WS_WIN0 = 16 * MiB, WS_WOUT0 = 40 * MiB, WS_WUP0 = 48 * MiB, WS_WDN0 = 92 * MiB;
constexpr size_t WS_WIN1 = 114 * MiB, WS_WOUT1 = 134 * MiB, WS_WUP1 = 142 * MiB, WS_WDN1 = 186 * MiB;
constexpr size_t WS_H = 208 * MiB;
constexpr size_t WS_P = 272 * MiB;
constexpr size_t WS_HB2 = 448 * MiB;
constexpr size_t WS_SSQ = 14 * MiB;
constexpr size_t WS_END = 512 * MiB;
constexpr int LDS_BYTES = 147456, HAL_OFF = 131072, MISC_OFF = HAL_OFF + 8192;
constexpr size_t CTL_ZERO_BYTES = 16384;

struct Params { const float* in[21]; float* out; unsigned char* ws; };

__device__ __forceinline__ unsigned pk2(float lo, float hi) { f32x2 v = {lo, hi}; bf16x2_t b = __builtin_convertvector(v, bf16x2_t); return __builtin_bit_cast(unsigned, b); }
__device__ __forceinline__ float bf2f(unsigned short b) { return __uint_as_float((unsigned)b << 16); }
__device__ __forceinline__ float bflo(unsigned w) { return __uint_as_float(w << 16); }
__device__ __forceinline__ float bfhi(unsigned w) { return __uint_as_float(w & 0xffff0000u); }
__device__ __forceinline__ float wave_sum(float v) {
#pragma unroll
    for (int o = 1; o < 64; o <<= 1) v += __shfl_xor(v, o);
    return v;
}
__device__ __forceinline__ int crow(int r, int hi) { return (r & 3) + 8 * (r >> 2) + 4 * hi; }
#define MFMA32(a, b, c) __builtin_amdgcn_mfma_f32_32x32x16_bf16((a), (b), (c), 0, 0, 0)


#define XB_TMO      128
#define XB_XCNT(j)  (256  + 64 * (j))
#define XB_XSUB(j)  (1280 + 64 * (j))
#define XB_XGEN(j)  (2304 + 64 * (j))
#define XB_TOP      3328
#define XB_TOPGEN   3392
#define XCD_BAR_WORDS 3456
#define XB_SPIN_CAP (1u << 30)
__device__ __forceinline__ unsigned xb_ld(unsigned* p)              { return __hip_atomic_load(p, __ATOMIC_RELAXED, __HIP_MEMORY_SCOPE_AGENT); }
__device__ __forceinline__ unsigned xb_add(unsigned* p, unsigned v) { return __hip_atomic_fetch_add(p, v, __ATOMIC_RELAXED, __HIP_MEMORY_SCOPE_AGENT); }
__device__ __forceinline__ unsigned xb_xcc_id() { return (unsigned)__builtin_amdgcn_s_getreg((3 << 11) | 20) & 0xFu; }
#define XB_SPIN(cond, bar) do { unsigned _sp = 0; while (cond) { __builtin_amdgcn_s_sleep(1); \
    if ((++_sp & 255u) == 0u) { if (xb_ld(&(bar)[XB_TMO])) break; if (_sp > XB_SPIN_CAP) { atomicAdd(&(bar)[XB_TMO], 1u); break; } } } } while (0)
struct XcdBarrier { unsigned* bar; unsigned x; volatile LAS unsigned* st; };
__device__ __forceinline__ XcdBarrier xcd_barrier_post(unsigned* bar, volatile LAS unsigned* st) {
    XcdBarrier b; b.bar = bar; b.x = xb_xcc_id(); b.st = st;
    if (threadIdx.x == 0) (void)xb_add(&bar[XB_XCNT(b.x)], 1u);
    return b;
}
__device__ __forceinline__ void xcd_barrier_complete(unsigned* bar, unsigned x, unsigned& nloc, unsigned& nx) {
    const unsigned G = gridDim.x * gridDim.y * gridDim.z;
    unsigned sum, cnt, mine, sp = 0u;
    for (;;) {
        sum = 0u; cnt = 0u; mine = 0u;
#pragma unroll
        for (unsigned j = 0; j < 16; ++j) { const unsigned c = xb_ld(&bar[XB_XCNT(j)]); sum += c; cnt += (c > 0u) ? 1u : 0u; mine = (j == x) ? c : mine; }
        if (sum == G) break;
        __builtin_amdgcn_s_sleep(1);
        if ((++sp & 255u) == 0u) { if (xb_ld(&bar[XB_TMO])) break; if (sp > XB_SPIN_CAP) { atomicAdd(&bar[XB_TMO], 1u); break; } }
    }
    nloc = mine > 0u ? mine : 1u; nx = cnt > 0u ? cnt : 1u;
}
__device__ __forceinline__ void xcd_barrier(const XcdBarrier& b) {
    asm volatile("s_waitcnt vmcnt(0)" ::: "memory");
    __syncthreads();
    if (threadIdx.x == 0) {
        unsigned* bar = b.bar;
        __builtin_amdgcn_s_waitcnt(0);
        unsigned nloc = b.st[0], nx = b.st[1];
        if (nloc == 0u) { xcd_barrier_complete(bar, b.x, nloc, nx); b.st[0] = nloc; b.st[1] = nx; }
        const unsigned old = xb_add(&bar[XB_XSUB(b.x)], 1u);
        const unsigned gen = old / nloc;
        if (old + 1u == (gen + 1u) * nloc) {
            __builtin_amdgcn_fence(__ATOMIC_RELEASE, "agent");
            asm volatile("s_waitcnt vmcnt(0)" ::: "memory");
            const unsigned og = xb_add(&bar[XB_TOP], 1u);
            const unsigned tg = og / nx;
            if (og + 1u == (tg + 1u) * nx) xb_add(&bar[XB_TOPGEN], 1u);
            else XB_SPIN(xb_ld(&bar[XB_TOPGEN]) == tg, bar);
            __builtin_amdgcn_fence(__ATOMIC_ACQUIRE, "agent");
            xb_add(&bar[XB_XGEN(b.x)], 1u);
            asm volatile("s_waitcnt vmcnt(0)" ::: "memory");
        } else {
            XB_SPIN(xb_ld(&bar[XB_XGEN(b.x)]) == gen, bar);
            __builtin_amdgcn_fence(__ATOMIC_ACQUIRE, "agent");
            asm volatile("s_waitcnt vmcnt(0)" ::: "memory");
        }
    }
    __syncthreads();
}


__device__ __forceinline__ void ctr_barrier(unsigned* cnt, unsigned target) {
    asm volatile("s_waitcnt vmcnt(0)" ::: "memory");
    __syncthreads();
    if (threadIdx.x == 0) {
        __builtin_amdgcn_fence(__ATOMIC_RELEASE, "agent");
        asm volatile("s_waitcnt vmcnt(0)" ::: "memory");
        (void)__hip_atomic_fetch_add(cnt, 1u, __ATOMIC_RELAXED, __HIP_MEMORY_SCOPE_AGENT);
        while (__hip_atomic_load(cnt, __ATOMIC_RELAXED, __HIP_MEMORY_SCOPE_AGENT) < target) __builtin_amdgcn_s_sleep(1);
        __builtin_amdgcn_fence(__ATOMIC_ACQUIRE, "agent");
        asm volatile("s_waitcnt vmcnt(0)" ::: "memory");
    }
    __syncthreads();
}

template <int MAP>
__device__ __forceinline__ void transpose_item(const float* __restrict__ W, int K, int ldw, int nblk, bf16* __restrict__ WT, LAS float* scr, int item, int lane, const float* __restrict__ gk = nullptr) {
    const int kb = item / nblk, nb = item % nblk, k0 = 64 * kb, n0 = 32 * nb;
#pragma unroll 8
    for (int i = 0; i < 8; ++i) { const int kk = 8 * i + (lane >> 3), n4 = (lane & 7) * 4; f32x4 w = *(const f32x4*)(W + (size_t)(k0 + kk) * ldw + n0 + n4); if (MAP == 1) w = w * gk[k0 + kk];
        scr[kk * 33 + n4] = w[0]; scr[kk * 33 + n4 + 1] = w[1]; scr[kk * 33 + n4 + 2] = w[2]; scr[kk * 33 + n4 + 3] = w[3]; }
    asm volatile("s_waitcnt lgkmcnt(0)" ::: "memory");
    int rb = n0;
    if (MAP == 1) { rb = (n0 < DFF) ? ((n0 >> 7) * 256 + (n0 & 127)) : ((((n0 - DFF) >> 7) * 256) + 128 + ((n0 - DFF) & 127)); }
    const int c = lane & 7;
#pragma unroll
    for (int j = 0; j < 4; ++j) { const int n = (lane >> 3) + 8 * j; const LAS float* s = scr + (8 * c) * 33 + n;
        u32x4 o; o.x = pk2(s[0 * 33], s[1 * 33]); o.y = pk2(s[2 * 33], s[3 * 33]); o.z = pk2(s[4 * 33], s[5 * 33]); o.w = pk2(s[6 * 33], s[7 * 33]);
        *(u32x4*)(WT + (size_t)(rb + n) * K + k0 + 8 * c) = o; }
    asm volatile("s_waitcnt lgkmcnt(0)" ::: "memory");
}

template <int MODE>
__device__ __forceinline__ void rms_rows(const float* X, const float* __restrict__ g, bf16* H, float* OutF, const LAS float* WfT, float* flog, int gw, int ngw, int lane) {
    f32x4 gv[8];
#pragma unroll
    for (int j = 0; j < 8; ++j) gv[j] = ((const f32x4*)g)[64 * j + lane];
    for (int m = gw; m < M; m += ngw) {
        const f32x4* xr = (const f32x4*)(X + (size_t)m * DM) + lane;
        f32x4 v[8]; float ss = 0.f;
#pragma unroll
        for (int j = 0; j < 8; ++j) { v[j] = xr[64 * j]; ss += (v[j].x * v[j].x + v[j].y * v[j].y) + (v[j].z * v[j].z + v[j].w * v[j].w); }
        const float rs = 1.0f / sqrtf(wave_sum(ss) * (1.0f / DM) + EPS);
#pragma unroll
        for (int j = 0; j < 8; ++j) v[j] = v[j] * rs * gv[j];
        if (MODE == 2) {
            f32x4* o = (f32x4*)(OutF + (size_t)m * DM) + lane;
#pragma unroll
            for (int j = 0; j < 8; ++j) o[64 * j] = v[j];
        } else {
            u32x2* o = (u32x2*)(H + (size_t)m * DM) + lane;
#pragma unroll
            for (int j = 0; j < 8; ++j) { u32x2 w; w.x = pk2(v[j].x, v[j].y); w.y = pk2(v[j].z, v[j].w); o[64 * j] = w; }
        }
        if (MODE == 1) {
            float a8[8];
#pragma unroll
            for (int jj = 0; jj < 8; ++jj) a8[jj] = 0.f;
#pragma unroll
            for (int j = 0; j < 8; ++j) {
#pragma unroll
                for (int jj = 0; jj < 8; ++jj) { const f32x4 w = *(const LAS f32x4*)(WfT + jj * DM + 4 * (64 * j + lane)); a8[jj] += (v[j].x * w.x + v[j].y * w.y) + (v[j].z * w.z + v[j].w * w.w); }
                asm volatile("" ::: "memory");
            }
            float mine = 0.f;
#pragma unroll
            for (int jj = 0; jj < 8; ++jj) { const float a = wave_sum(a8[jj]); if (lane == jj) mine = a; }
            if (lane < 8) flog[(size_t)m * 8 + lane] = mine;
        }
    }
}

__device__ __forceinline__ float wave_sum8(const float (&a8)[8], int lane) {
    const bool b2 = (lane & 4) != 0, b1 = (lane & 2) != 0, b0 = (lane & 1) != 0;
    float bq[4], cq[2], r;
#pragma unroll
    for (int i = 0; i < 4; ++i) { const float snd = b2 ? a8[i] : a8[i + 4]; const float rcv = __shfl_xor(snd, 4); bq[i] = (b2 ? a8[i + 4] : a8[i]) + rcv; }
#pragma unroll
    for (int i = 0; i < 2; ++i) { const float snd = b1 ? bq[i] : bq[i + 2]; const float rcv = __shfl_xor(snd, 2); cq[i] = (b1 ? bq[i + 2] : bq[i]) + rcv; }
    { const float snd = b0 ? cq[0] : cq[1]; const float rcv = __shfl_xor(snd, 1); r = (b0 ? cq[1] : cq[0]) + rcv; }
    r += __shfl_xor(r, 8); r += __shfl_xor(r, 16); r += __shfl_xor(r, 32);
    return r;
}
__device__ __forceinline__ void rms1_rows_bf16(const bf16* Xb, const float* __restrict__ ssq, const float* __restrict__ g, bf16* H, const LAS float* WfT, float* flog, int gw, int ngw, int lane) {
    f32x4 gv[8];
#pragma unroll
    for (int j = 0; j < 8; ++j) gv[j] = ((const f32x4*)g)[64 * j + lane];
    for (int m = gw; m < M; m += 2 * ngw) {
        const bool two = (m + ngw) < M; const int mB = two ? m + ngw : m;
        const float partA = (lane < 32) ? ssq[(size_t)m * 32 + lane] : 0.f, partB = (lane < 32) ? ssq[(size_t)mB * 32 + lane] : 0.f;
        const u32x2* xrA = (const u32x2*)(Xb + (size_t)m * DM) + lane; const u32x2* xrB = (const u32x2*)(Xb + (size_t)mB * DM) + lane;
        u32x2 xa[8], xb[8];
#pragma unroll
        for (int j = 0; j < 8; ++j) { xa[j] = xrA[64 * j]; xb[j] = xrB[64 * j]; }
        const float rsA = 1.0f / sqrtf(wave_sum(partA) * (1.0f / DM) + EPS), rsB = 1.0f / sqrtf(wave_sum(partB) * (1.0f / DM) + EPS);
        f32x4 vA[8], vB[8];
#pragma unroll
        for (int j = 0; j < 8; ++j) {
            vA[j].x = bflo(xa[j].x); vA[j].y = bfhi(xa[j].x); vA[j].z = bflo(xa[j].y); vA[j].w = bfhi(xa[j].y); vA[j] = vA[j] * rsA * gv[j];
            vB[j].x = bflo(xb[j].x); vB[j].y = bfhi(xb[j].x); vB[j].z = bflo(xb[j].y); vB[j].w = bfhi(xb[j].y); vB[j] = vB[j] * rsB * gv[j]; }
        { u32x2* o = (u32x2*)(H + (size_t)m * DM) + lane;
#pragma unroll
          for (int j = 0; j < 8; ++j) { u32x2 w; w.x = pk2(vA[j].x, vA[j].y); w.y = pk2(vA[j].z, vA[j].w); o[64 * j] = w; } }
        if (two) { u32x2* o = (u32x2*)(H + (size_t)mB * DM) + lane;
#pragma unroll
          for (int j = 0; j < 8; ++j) { u32x2 w; w.x = pk2(vB[j].x, vB[j].y); w.y = pk2(vB[j].z, vB[j].w); o[64 * j] = w; } }
        float aA[8], aB[8];
#pragma unroll
        for (int jj = 0; jj < 8; ++jj) { aA[jj] = 0.f; aB[jj] = 0.f; }
#pragma unroll
        for (int j = 0; j < 8; ++j) {
#pragma unroll
            for (int jj = 0; jj < 8; ++jj) { const f32x4 w = *(const LAS f32x4*)(WfT + jj * DM + 4 * (64 * j + lane));
                aA[jj] += (vA[j].x * w.x + vA[j].y * w.y) + (vA[j].z * w.z + vA[j].w * w.w);
                aB[jj] += (vB[j].x * w.x + vB[j].y * w.y) + (vB[j].z * w.z + vB[j].w * w.w); }
            asm volatile("" ::: "memory");
        }
        const float mineA = wave_sum8(aA, lane), mineB = wave_sum8(aB, lane);
        if (lane < 8) { flog[(size_t)m * 8 + lane] = mineA; if (two) flog[(size_t)mB * 8 + lane] = mineB; }
    }
}

constexpr int KS_PITCH = 272, VT_PITCH = 144, KBUF = 64 * KS_PITCH, VBUF = 128 * VT_PITCH, KS_OFF = 0, VT_OFF = 2 * KBUF, CS_OFF = VT_OFF + 2 * VBUF, SCAN_OFF = CS_OFF + 8192;
struct KVRegs { u32x4 k[2]; u32x4 v[2]; };
__device__ __forceinline__ void kv_load(KVRegs& R, const bf16* Kg, const bf16* Vg, int ldp, int tid) {
#pragma unroll
    for (int i = 0; i < 2; ++i) { const int c = tid + 512 * i; R.k[i] = *(const u32x4*)(Kg + (size_t)(c >> 4) * ldp + (c & 15) * 8); }
    const int kp = tid & 31, dg = tid >> 5;
    R.v[0] = *(const u32x4*)(Vg + (size_t)(2 * kp) * ldp + dg * 8); R.v[1] = *(const u32x4*)(Vg + (size_t)(2 * kp + 1) * ldp + dg * 8);
}
__device__ __forceinline__ void kv_store(const KVRegs& R, LAS unsigned char* lds, int tid, int buf) {
#pragma unroll
    for (int i = 0; i < 2; ++i) { const int c = tid + 512 * i; *(LAS u32x4*)(lds + KS_OFF + buf * KBUF + (c >> 4) * KS_PITCH + (c & 15) * 16) = R.k[i]; }
    const int kp = tid & 31, dg = tid >> 5;
    const int kk_ = (2 * kp) & 15, g_ = kk_ >> 2, vpos = (((2 * kp) >> 4) * 16 + ((((g_ & 1) << 1) | (g_ >> 1)) * 4) + (kk_ & 3)) * 2;
#pragma unroll
    for (int i = 0; i < 8; ++i) { const unsigned a = (R.v[0][i >> 1] >> (16 * (i & 1))) & 0xffffu, b = (R.v[1][i >> 1] >> (16 * (i & 1))) & 0xffffu;
        *(LAS unsigned*)(lds + VT_OFF + buf * VBUF + (dg * 8 + i) * VT_PITCH + vpos) = a | (b << 16); }
}
__device__ __forceinline__ bf16x8 pack8(const f32x16& x, int s8) {
    u32x4 p; p.x = pk2(x[s8], x[s8 + 1]); p.y = pk2(x[s8 + 2], x[s8 + 3]); p.z = pk2(x[s8 + 4], x[s8 + 5]); p.w = pk2(x[s8 + 6], x[s8 + 7]);
    return __builtin_bit_cast(bf16x8, p);
}
__device__ __forceinline__ void pv_tile(f32x16 (&o)[4], const f32x16& p0, const f32x16& p1, const LAS unsigned char* vbase, int r32, int hh) {
    bf16x8 pf[4]; pf[0] = pack8(p0, 0); pf[1] = pack8(p0, 8); pf[2] = pack8(p1, 0); pf[3] = pack8(p1, 8);
#pragma unroll
    for (int db = 0; db < 4; ++db)
#pragma unroll
        for (int s = 0; s < 4; ++s) {
            const bf16x8 a = *(const LAS bf16x8*)(vbase + (db * 32 + r32) * VT_PITCH + (16 * s + 8 * hh) * 2);
            o[db] = MFMA32(a, pf[s], o[db]);
        }
}
__device__ __forceinline__ void qk_tile(f32x16& s0, f32x16& s1, const bf16x8 (&qf)[8], const LAS unsigned char* kbase, int r32, int hh) {
#pragma unroll
    for (int dh = 0; dh < 2; ++dh) {
        bf16x8 k0[4], k1[4];
#pragma unroll
        for (int d = 0; d < 4; ++d) { const int d0 = 4 * dh + d; k0[d] = *(const LAS bf16x8*)(kbase + r32 * KS_PITCH + d0 * 32 + hh * 16); k1[d] = *(const LAS bf16x8*)(kbase + (32 + r32) * KS_PITCH + d0 * 32 + hh * 16); }
        asm volatile("" ::: "memory");
#pragma unroll
        for (int d = 0; d < 4; ++d) { s0 = MFMA32(k0[d], qf[4 * dh + d], s0); s1 = MFMA32(k1[d], qf[4 * dh + d], s1); }
    }
}

constexpr float QSCALE2 = ATT_SCALE * 1.4426950408889634f, LOG2E = 1.4426950408889634f;
template <int MODE>
__device__ __forceinline__ void attn_item(LAS unsigned char* lds, const bf16* __restrict__ P, int ldp, int qoff, int koff, int voff, bf16* __restrict__ cat, int catoff,
                                          int b, int h, int qb, const float* __restrict__ flog, float bfh) {
    const int tid = opaque_tid(), lane = tid & 63, wid = __builtin_amdgcn_readfirstlane(tid >> 6), r32 = lane & 31, hh = lane >> 5;
    const size_t rowbase = (size_t)b * SEQ; const int q0 = qb * 256;
    const int t = q0 + wid * 32 + r32;
    const int wtmin = q0 + wid * 32, wtmax = wtmin + 31;
    LAS float* cs = (LAS float*)(lds + CS_OFF);
    __syncthreads();
    if (MODE == 1) {
        LAS float* sc = (LAS float*)(lds + SCAN_OFF);
        float v[4]; float run = 0.f;
#pragma unroll
        for (int i = 0; i < 4; ++i) { const float x = flog[(rowbase + tid * 4 + i) * 8 + h] + bfh; const float lf = fminf(x, 0.f) - __logf(1.0f + __expf(-fabsf(x))); run += lf; v[i] = run; }
        float incl = run;
#pragma unroll
        for (int o = 1; o < 64; o <<= 1) { const float y = __shfl_up(incl, o); if (lane >= o) incl += y; }
        if (lane == 63) sc[wid] = incl;
        __syncthreads();
        float base = incl - run;
        for (int w = 0; w < wid; ++w) base += sc[w];
#pragma unroll
        for (int i = 0; i < 4; ++i) cs[tid * 4 + i] = (base + v[i]) * LOG2E;
        __syncthreads();
    }
    bf16x8 qf[8];
    { const bf16* qp = P + (rowbase + t) * ldp + qoff + h * 128 + hh * 8;
#pragma unroll
      for (int d0 = 0; d0 < 8; ++d0) { const u32x4 q = *(const u32x4*)(qp + d0 * 16); u32x4 w;
#pragma unroll
          for (int e = 0; e < 4; ++e) w[e] = pk2(bflo(q[e]) * QSCALE2, bfhi(q[e]) * QSCALE2);
          qf[d0] = __builtin_bit_cast(bf16x8, w); } }
    f32x16 o[4];
#pragma unroll
    for (int db = 0; db < 4; ++db)
#pragma unroll
        for (int i = 0; i < 16; ++i) o[db][i] = 0.f;
    const bf16* Kh = P + rowbase * ldp + koff + h * 128; const bf16* Vh = P + rowbase * ldp + voff + h * 128;
    const int ntiles = (q0 + 256) / 64;
    float carry = 1.f;
    LAS unsigned* flg = (LAS unsigned*)(lds + SCAN_OFF);
    float mrun = -INFINITY, lsum = 0.f;
    const float ct = (MODE == 1) ? cs[t] : 0.f;
    KVRegs R;
    kv_load(R, Kh + (size_t)(ntiles - 1) * 64 * ldp, Vh + (size_t)(ntiles - 1) * 64 * ldp, ldp, tid);
    kv_store(R, lds, tid, 0);
    __syncthreads();
    for (int it = 0; it < ntiles; ++it) {
        const int jt = ntiles - 1 - it; const int kt0 = jt * 64; const int buf = it & 1;
        if (MODE == 0 && it > 0) { unsigned all = 1u;
#pragma unroll
            for (int w = 0; w < 8; ++w) all &= flg[(buf ^ 1) * 8 + w];
            if (all) break; }
        if (it + 1 < ntiles) kv_load(R, Kh + (size_t)(jt - 1) * 64 * ldp, Vh + (size_t)(jt - 1) * 64 * ldp, ldp, tid);
        const LAS unsigned char* kbase = lds + KS_OFF + buf * KBUF; const LAS unsigned char* vbase = lds + VT_OFF + buf * VBUF;
        if (kt0 > wtmax) { if (MODE == 0 && lane == 0) flg[buf * 8 + wid] = 0u; }
        else {
        f32x16 s0, s1;
        if (MODE == 0) {
#pragma unroll
            for (int i = 0; i < 16; ++i) { s0[i] = 0.f; s1[i] = 0.f; }
            qk_tile(s0, s1, qf, kbase, r32, hh);
            f32x16 L0, L1;
#pragma unroll
            for (int r = 0; r < 16; ++r) {
                { const float z = s0[r]; const float e = __builtin_amdgcn_exp2f(-fabsf(z)); const float rr = __builtin_amdgcn_rcpf(1.0f + e), er = e * rr; const bool pz = z >= 0.f; s0[r] = pz ? rr : er; L0[r] = pz ? er : rr; }
                { const float z = s1[r]; const float e = __builtin_amdgcn_exp2f(-fabsf(z)); const float rr = __builtin_amdgcn_rcpf(1.0f + e), er = e * rr; const bool pz = z >= 0.f; s1[r] = pz ? rr : er; L1[r] = pz ? er : rr; } }
            if (kt0 + 63 >= wtmin) {
#pragma unroll
                for (int r = 0; r < 16; ++r) { const int key = kt0 + crow(r, hh);
                    if (!(key < t)) { s0[r] = 0.f; L0[r] = 1.f; }
                    if (!(key + 32 < t)) { s1[r] = 0.f; L1[r] = 1.f; } }
            }
            float G0[4], G1[4], PG0[4], PG1[4], S0[4], S1[4];
#pragma unroll
            for (int g = 0; g < 4; ++g) { G0[g] = (L0[4 * g] * L0[4 * g + 1]) * (L0[4 * g + 2] * L0[4 * g + 3]); G1[g] = (L1[4 * g] * L1[4 * g + 1]) * (L1[4 * g + 2] * L1[4 * g + 3]); }
#pragma unroll
            for (int g = 0; g < 4; ++g) { PG0[g] = __shfl_xor(G0[g], 32); PG1[g] = __shfl_xor(G1[g], 32); }
            float run = carry;
#pragma unroll
            for (int g = 3; g >= 0; --g) { S1[g] = (hh == 0) ? run * PG1[g] : run; run *= G1[g] * PG1[g]; }
#pragma unroll
            for (int g = 3; g >= 0; --g) { S0[g] = (hh == 0) ? run * PG0[g] : run; run *= G0[g] * PG0[g]; }
            carry = run;
#pragma unroll
            for (int g = 0; g < 4; ++g) {
                float later0 = S0[g], later1 = S1[g];
#pragma unroll
                for (int e = 3; e >= 0; --e) { const int r = 4 * g + e;
                    s0[r] *= later0; later0 *= L0[r];
                    s1[r] *= later1; later1 *= L1[r]; }
            }
            { const bool wd = __all(carry == 0.f); if (lane == 0) flg[buf * 8 + wid] = wd ? 1u : 0u; }
        } else {
#pragma unroll
            for (int g = 0; g < 4; ++g) { const f32x4 c0 = *(const LAS f32x4*)(cs + kt0 + 8 * g + 4 * hh), c1 = *(const LAS f32x4*)(cs + kt0 + 32 + 8 * g + 4 * hh);
#pragma unroll
                for (int e = 0; e < 4; ++e) { s0[4 * g + e] = ct - c0[e]; s1[4 * g + e] = ct - c1[e]; } }
            qk_tile(s0, s1, qf, kbase, r32, hh);
            if (kt0 + 63 > wtmin) {
#pragma unroll
                for (int r = 0; r < 16; ++r) { const int key = kt0 + crow(r, hh);
                    if (key > t) s0[r] = -INFINITY;
                    if (key + 32 > t) s1[r] = -INFINITY; }
            }
            float mx = fmaxf(s0[0], s1[0]);
#pragma unroll
            for (int r = 1; r < 16; ++r) mx = fmaxf(fmaxf(mx, s0[r]), s1[r]);
            mx = fmaxf(mx, __shfl_xor(mx, 32));
            const float mnew = fmaxf(mrun, mx); const float muse = (mnew == -INFINITY) ? 0.f : mnew;
            const float alpha = __builtin_amdgcn_exp2f(mrun - muse);
            float ps = 0.f;
#pragma unroll
            for (int r = 0; r < 16; ++r) { s0[r] = __builtin_amdgcn_exp2f(s0[r] - muse); s1[r] = __builtin_amdgcn_exp2f(s1[r] - muse); ps += s0[r] + s1[r]; }
            lsum = lsum * alpha + ps; mrun = mnew;
            if (__any(alpha != 1.0f)) {
#pragma unroll
                for (int db = 0; db < 4; ++db)
#pragma unroll
                    for (int i = 0; i < 16; ++i) o[db][i] *= alpha; }
        }
        pv_tile(o, s0, s1, vbase, r32, hh);
        }
        if (it + 1 < ntiles) kv_store(R, lds, tid, buf ^ 1);
        __syncthreads();
    }
    float inv = 1.0f;
    if (MODE == 1) { const float lt = lsum + __shfl_xor(lsum, 32); inv = 1.0f / lt; }
    bf16* op = cat + (rowbase + t) * DM + catoff + h * 128;
#pragma unroll
    for (int db = 0; db < 4; ++db)
#pragma unroll
        for (int g = 0; g < 4; ++g) { u32x2 w; w.x = pk2(o[db][4 * g] * inv, o[db][4 * g + 1] * inv); w.y = pk2(o[db][4 * g + 2] * inv, o[db][4 * g + 3] * inv);
            *(u32x2*)(op + db * 32 + 8 * g + 4 * hh) = w; }
}

__device__ __forceinline__ void shortconv_phase(const bf16* __restrict__ P, const float* __restrict__ w, bf16* __restrict__ cat, size_t gt, size_t gs) {
    for (size_t i = gt; i < (size_t)(M / 8) * 128; i += gs) {
        const int cg8 = (int)(i & 127), m0 = (int)(i >> 7) * 8, tpos0 = m0 & (SEQ - 1), c0 = cg8 * 8;
        float w0[8], w1[8], w2[8];
        { const f32x4 a = *(const f32x4*)(w + c0), b = *(const f32x4*)(w + c0 + 4), c = *(const f32x4*)(w + 1024 + c0), d = *(const f32x4*)(w + 1024 + c0 + 4), e = *(const f32x4*)(w + 2048 + c0), f = *(const f32x4*)(w + 2048 + c0 + 4);
#pragma unroll
          for (int k = 0; k < 4; ++k) { w0[k] = a[k]; w0[4 + k] = b[k]; w1[k] = c[k]; w1[4 + k] = d[k]; w2[k] = e[k]; w2[4 + k] = f[k]; } }
        float p2[8], p1[8];
#pragma unroll
        for (int e = 0; e < 8; ++e) { p2[e] = 0.f; p1[e] = 0.f; }
        if (tpos0 >= 2) {
            const bf16* r2 = P + (size_t)(m0 - 2) * NIN0; const bf16* r1 = r2 + NIN0;
            const u32x4 gc2 = *(const u32x4*)(r2 + 4096 + c0), hn2 = *(const u32x4*)(r2 + 5120 + c0), gc1 = *(const u32x4*)(r1 + 4096 + c0), hn1 = *(const u32x4*)(r1 + 5120 + c0);
#pragma unroll
            for (int e = 0; e < 4; ++e) { p2[2 * e] = bflo(gc2[e]) * bflo(hn2[e]); p2[2 * e + 1] = bfhi(gc2[e]) * bfhi(hn2[e]); p1[2 * e] = bflo(gc1[e]) * bflo(hn1[e]); p1[2 * e + 1] = bfhi(gc1[e]) * bfhi(hn1[e]); }
        }
#pragma unroll
        for (int j = 0; j < 8; ++j) {
            const bf16* row = P + (size_t)(m0 + j) * NIN0;
            const u32x4 gb = *(const u32x4*)(row + 3072 + c0), gc = *(const u32x4*)(row + 4096 + c0), hn = *(const u32x4*)(row + 5120 + c0);
            float p0[8];
#pragma unroll
            for (int e = 0; e < 4; ++e) { p0[2 * e] = bflo(gc[e]) * bflo(hn[e]); p0[2 * e + 1] = bfhi(gc[e]) * bfhi(hn[e]); }
            u32x4 ow;
#pragma unroll
            for (int e = 0; e < 4; ++e) { const float y0 = w0[2 * e] * p2[2 * e] + w1[2 * e] * p1[2 * e] + w2[2 * e] * p0[2 * e], y1 = w0[2 * e + 1] * p2[2 * e + 1] + w1[2 * e + 1] * p1[2 * e + 1] + w2[2 * e + 1] * p0[2 * e + 1];
                ow[e] = pk2(bflo(gb[e]) * y0, bfhi(gb[e]) * y1); }
            *(u32x4*)(cat + (size_t)(m0 + j) * DM + 1024 + c0) = ow;
#pragma unroll
            for (int e = 0; e < 8; ++e) { p2[e] = p1[e]; p1[e] = p0[e]; }
        }
    }
}

__device__ __forceinline__ void gmlp_stats(LAS unsigned char* lds, const bf16* __restrict__ P, int b, int n) {
    const int tid = opaque_tid(), lane = tid & 63, wid = __builtin_amdgcn_readfirstlane(tid >> 6);
    const size_t row0 = (size_t)b * SEQ + (size_t)n * 128;
    LAS float* stat = (LAS float*)lds;
    __syncthreads();
#pragma unroll 1
    for (int hb = 0; hb < 2; ++hb) {
        u32x4 av[8], cv[8];
#pragma unroll
        for (int i = 0; i < 8; ++i) { const bf16* vp = P + (row0 + wid * 16 + hb * 8 + i) * NIN1 + 1024 + lane * 16; av[i] = *(const u32x4*)vp; cv[i] = *(const u32x4*)(vp + 8); }
        float s1[8], s2[8];
#pragma unroll
        for (int i = 0; i < 8; ++i) { float a = 0.f, q = 0.f;
#pragma unroll
            for (int e = 0; e < 4; ++e) { const float x0 = bflo(av[i][e]), x1 = bfhi(av[i][e]), x2 = bflo(cv[i][e]), x3 = bfhi(cv[i][e]); a += (x0 + x1) + (x2 + x3); q += (x0 * x0 + x1 * x1) + (x2 * x2 + x3 * x3); }
            s1[i] = a; s2[i] = q; }
        const float t1 = wave_sum8(s1, lane), t2 = wave_sum8(s2, lane);
        const float mean = t1 * (1.0f / 1024.0f);
        const float var = fmaxf(t2 * (1.0f / 1024.0f) - mean * mean, 0.f);
        if (lane < 8) { const int tk = wid * 16 + hb * 8 + lane; stat[2 * tk] = mean; stat[2 * tk + 1] = 1.0f / sqrtf(var + EPS); }
    }
    __syncthreads();
}
__device__ __forceinline__ void gmlp_item(LAS unsigned char* lds, const bf16* __restrict__ P, const float* __restrict__ sgw, const float* __restrict__ sgb, const float* __restrict__ gn,
                                          bf16* __restrict__ cat, int b, int n, int g) {
    const int tid = opaque_tid(), lane = tid & 63, wid = __builtin_amdgcn_readfirstlane(tid >> 6), r32 = lane & 31, hh = lane >> 5;
    const size_t row0 = (size_t)b * SEQ + (size_t)n * 128;
    LAS float* stat = (LAS float*)lds;
    LAS unsigned char* vnT = lds + 1024;
    LAS unsigned char* Wl = lds + 1024 + 128 * 272;
    __syncthreads();
    f32x4 wa[4], wc[4]; u32x4 va[2], vc[2];
#pragma unroll
    for (int i = 0; i < 4; ++i) { const int task = tid + 512 * i, tt = task >> 4, s8 = (task & 15) * 8; const float* wp = sgw + ((size_t)g * 128 + tt) * 128 + s8; wa[i] = *(const f32x4*)wp; wc[i] = *(const f32x4*)(wp + 4); }
#pragma unroll
    for (int i = 0; i < 2; ++i) { const int task = tid + 512 * i, sp = task & 63, c8 = task >> 6; const bf16* vp = P + (row0 + 2 * sp) * NIN1 + 1024 + g * 128 + c8 * 8; va[i] = *(const u32x4*)vp; vc[i] = *(const u32x4*)(vp + NIN1); }
#pragma unroll
    for (int i = 0; i < 2; ++i) { const int task = tid + 512 * i, sp = task & 63, c8 = task >> 6;
        const u32x4 a = va[i], c = vc[i];
        const float m0 = stat[4 * sp], r0 = stat[4 * sp + 1], m1 = stat[4 * sp + 2], r1 = stat[4 * sp + 3];
        const f32x4 g0 = *(const f32x4*)(gn + g * 128 + c8 * 8), g1 = *(const f32x4*)(gn + g * 128 + c8 * 8 + 4);
#pragma unroll
        for (int e = 0; e < 8; ++e) { const float gg = (e < 4) ? g0[e & 3] : g1[e & 3];
            const float x0 = (e & 1) ? bfhi(a[e >> 1]) : bflo(a[e >> 1]), x1 = (e & 1) ? bfhi(c[e >> 1]) : bflo(c[e >> 1]);
            *(LAS unsigned*)(vnT + (c8 * 8 + e) * 272 + sp * 4) = pk2((x0 - m0) * r0 * gg, (x1 - m1) * r1 * gg); } }
#pragma unroll
    for (int i = 0; i < 4; ++i) { const int task = tid + 512 * i, tt = task >> 4, s8 = (task & 15) * 8;
        float x[8] = {wa[i].x, wa[i].y, wa[i].z, wa[i].w, wc[i].x, wc[i].y, wc[i].z, wc[i].w};
#pragma unroll
        for (int e = 0; e < 8; ++e) if (s8 + e > tt) x[e] = 0.f;
        u32x4 w; w.x = pk2(x[0], x[1]); w.y = pk2(x[2], x[3]); w.z = pk2(x[4], x[5]); w.w = pk2(x[6], x[7]);
        *(LAS u32x4*)(Wl + tt * 272 + s8 * 2) = w; }
    __syncthreads();
    const int tb = wid & 3, chf = wid >> 2;
    f32x16 acc[2];
#pragma unroll
    for (int cb = 0; cb < 2; ++cb)
#pragma unroll
        for (int i = 0; i < 16; ++i) acc[cb][i] = 0.f;
#pragma unroll
    for (int s0 = 0; s0 < 8; ++s0) {
        const bf16x8 a = *(const LAS bf16x8*)(Wl + (32 * tb + r32) * 272 + s0 * 32 + hh * 16);
#pragma unroll
        for (int cb = 0; cb < 2; ++cb) { const bf16x8 bb = *(const LAS bf16x8*)(vnT + (64 * chf + 32 * cb + r32) * 272 + s0 * 32 + hh * 16); acc[cb] = MFMA32(a, bb, acc[cb]); }
    }
    LAS float* ot = (LAS float*)(lds + 1024 + 2 * 128 * 272);
#pragma unroll
    for (int cb = 0; cb < 2; ++cb)
#pragma unroll
        for (int r = 0; r < 16; ++r) ot[(32 * tb + crow(r, hh)) * 132 + 64 * chf + 32 * cb + r32] = acc[cb][r];
    __syncthreads();
#pragma unroll
    for (int i = 0; i < 4; ++i) { const int task = tid + 512 * i, tt = task >> 4, c8 = (task & 15) * 8;
        const u32x4 uv = *(const u32x4*)(P + (row0 + tt) * NIN1 + g * 128 + c8);
        const f32x4 m0 = *(const LAS f32x4*)(ot + tt * 132 + c8), m1 = *(const LAS f32x4*)(ot + tt * 132 + c8 + 4);
        const float bs = sgb[g * 128 + tt];
        u32x4 ow;
        ow.x = pk2(bflo(uv.x) * (m0[0] + bs), bfhi(uv.x) * (m0[1] + bs)); ow.y = pk2(bflo(uv.y) * (m0[2] + bs), bfhi(uv.y) * (m0[3] + bs));
        ow.z = pk2(bflo(uv.z) * (m1[0] + bs), bfhi(uv.z) * (m1[1] + bs)); ow.w = pk2(bflo(uv.w) * (m1[2] + bs), bfhi(uv.w) * (m1[3] + bs));
        *(u32x4*)(cat + (row0 + tt) * DM + g * 128 + c8) = ow; }
}

__device__ __forceinline__ void fixup_tile(const float* __restrict__ side, const float* __restrict__ cw, bf16* __restrict__ act, int pm, int tid) {
    for (int idx = tid; idx < 2 * (DFF / 4); idx += 512) {
        const int j = idx / (DFF / 4), ch = (idx % (DFF / 4)) * 4;
        const int colg = (ch >> 7) * 256 + (ch & 127), colu = colg + 128;
        f32x4 yg = *(const f32x4*)(side + (size_t)(pm * 4 + j) * NUP + colg), yu = *(const f32x4*)(side + (size_t)(pm * 4 + j) * NUP + colu);
        if (pm & 7) {
            const f32x4 g255 = *(const f32x4*)(side + (size_t)((pm - 1) * 4 + 3) * NUP + colg), g254 = *(const f32x4*)(side + (size_t)((pm - 1) * 4 + 2) * NUP + colg);
            const f32x4 u255 = *(const f32x4*)(side + (size_t)((pm - 1) * 4 + 3) * NUP + colu), u254 = *(const f32x4*)(side + (size_t)((pm - 1) * 4 + 2) * NUP + colu);
            const f32x4 wg0 = *(const f32x4*)(cw + ch), wg1 = *(const f32x4*)(cw + NUP + ch), wu0 = *(const f32x4*)(cw + DFF + ch), wu1 = *(const f32x4*)(cw + NUP + DFF + ch);
            if (j == 0) { yg += wg1 * g255 + wg0 * g254; yu += wu1 * u255 + wu0 * u254; } else { yg += wg0 * g255; yu += wu0 * u255; }
        }
        u32x2 w; w.x = pk2(pg8::silu_f(yg[0]) * yu[0], pg8::silu_f(yg[1]) * yu[1]); w.y = pk2(pg8::silu_f(yg[2]) * yu[2], pg8::silu_f(yg[3]) * yu[3]);
        *(u32x2*)(act + (size_t)(pm * 256 + j) * DFF + ch) = w;
    }
}

__global__ void __launch_bounds__(512, 2) fwd(Params P) {
    extern __shared__ __attribute__((aligned(16))) unsigned char lds_raw[];
    LAS unsigned char* lds = (LAS unsigned char*)lds_raw;
    cg::grid_group grid = cg::this_grid();
    const int G = gridDim.x, bx = blockIdx.x;
#define PH_IDX const int tid = opaque_tid(), lane = tid & 63, wave = __builtin_amdgcn_readfirstlane(tid >> 6); const int gw = bx * 8 + wave, ngw = G * 8; const size_t gt = (size_t)bx * 512 + tid, gs = (size_t)G * 512; (void)lane; (void)gw; (void)ngw; (void)gt; (void)gs;
    unsigned char* ws = P.ws;
    float* flog = (float*)(ws + WS_FLOG); float* side = (float*)(ws + WS_SIDE);
#define Wt_in(l) ((bf16*)(ws + ((l) == 0 ? WS_WIN0 : WS_WIN1)))
#define Wt_out(l) ((bf16*)(ws + ((l) == 0 ? WS_WOUT0 : WS_WOUT1)))
#define Wt_up(l) ((bf16*)(ws + ((l) == 0 ? WS_WUP0 : WS_WUP1)))
#define Wt_dn(l) ((bf16*)(ws + ((l) == 0 ? WS_WDN0 : WS_WDN1)))
    bf16* Hb = (bf16*)(ws + WS_H); bf16* Pb = (bf16*)(ws + WS_P); bf16* Hb2 = (bf16*)(ws + WS_HB2); float* ssq = (float*)(ws + WS_SSQ);
    float* X = P.out;
    LAS float* hal = (LAS float*)(lds + HAL_OFF);
    if (threadIdx.x < 8) ((volatile LAS unsigned*)(lds + MISC_OFF))[threadIdx.x] = 0u;
    __syncthreads();
    if (blockIdx.x == 0) { for (int i = threadIdx.x; i < XCD_BAR_WORDS; i += 512) __hip_atomic_store((unsigned*)ws + i, 0u, __ATOMIC_RELAXED, __HIP_MEMORY_SCOPE_AGENT); }

    {
        PH_IDX
        LAS float* scr = (LAS float*)(lds + wave * 16384);
        constexpr int I_IN0 = 32 * 192, I_OUT = 32 * 64, I_UP = 32 * 352, I_DN = 88 * 64, I_IN1 = 32 * 160;
        constexpr int NITEMS = I_IN0 + I_IN1 + 2 * (I_OUT + I_UP + I_DN);
#ifndef SKIP_TR
        for (int it = gw; it < NITEMS; it += ngw) {
            int r = it;
            if (r < I_IN0) { transpose_item<0>(P.in[2], DM, NIN0, 192, Wt_in(0), scr, r, lane); continue; } r -= I_IN0;
            if (r < I_IN1) { transpose_item<0>(P.in[10], DM, LDW1, 160, Wt_in(1), scr, r, lane); continue; } r -= I_IN1;
            if (r < I_OUT) { transpose_item<0>(P.in[4], DM, DM, 64, Wt_out(0), scr, r, lane); continue; } r -= I_OUT;
            if (r < I_OUT) { transpose_item<0>(P.in[15], DM, DM, 64, Wt_out(1), scr, r, lane); continue; } r -= I_OUT;
            if (r < I_UP) { transpose_item<1>(P.in[6], DM, NUP, 352, Wt_up(0), scr, r, lane, P.in[5]); continue; } r -= I_UP;
            if (r < I_UP) { transpose_item<1>(P.in[17], DM, NUP, 352, Wt_up(1), scr, r, lane, P.in[16]); continue; } r -= I_UP;
            if (r < I_DN) { transpose_item<0>(P.in[8], DFF, DM, 64, Wt_dn(0), scr, r, lane); continue; } r -= I_DN;
            transpose_item<0>(P.in[19], DFF, DM, 64, Wt_dn(1), scr, r, lane);
        }
#endif
        rms_rows<0>(P.in[0], P.in[1], Hb, nullptr, nullptr, nullptr, gw, ngw, lane);
    }
    grid.sync();
#ifdef USE_CG_SYNC
#define GSYNC() grid.sync()
#elif defined(USE_CTR_SYNC)
    unsigned bar_round = 0;
#define GSYNC() do { ++bar_round; ctr_barrier((unsigned*)ws + 64, bar_round * (unsigned)G); } while (0)
#else
#ifdef XB_FENCE_ALL
#define GSYNC() xcd_barrier(xbar)
#else
#define GSYNC() xcd_barrier(xbar)
#endif
#endif
    const XcdBarrier xbar = xcd_barrier_post((unsigned*)ws, (volatile LAS unsigned*)(lds + MISC_OFF));

    for (int layer = 0; layer < 2; ++layer) {
        {
            const int N = layer == 0 ? NIN0 : NIN1;
            pg8::Gemm g{Hb, Wt_in(layer), M, N, DM}; pg8::StaticOrder S; S.init(M, N, G, bx);
            pg8::EpiStore E{Pb, N, layer == 0 ? 0 : 8};
#ifndef SKIP_IN
            pg8::gemm_phase<pg8::EpiStore, pg8::StaticOrder, true, true>(lds, g, S, E);
#endif
        }
        GSYNC();
#ifdef PROBE_SYNC
        for (int i = 0; i < 10; ++i) GSYNC();
#endif
#ifdef PROBE_MIX
        for (int rep = 0; rep < 2; ++rep)
#endif
        if (layer == 0) {
            PH_IDX
            for (int pi = bx; pi < 256; pi += G) { const int bh = pi >> 2, s = pi & 3;
#ifndef SKIP_ATT0
                attn_item<0>(lds, Pb, NIN0, 0, 1024, 2048, Hb, 0, bh >> 3, bh & 7, 7 - s, nullptr, 0.f);
                attn_item<0>(lds, Pb, NIN0, 0, 1024, 2048, Hb, 0, bh >> 3, bh & 7, s, nullptr, 0.f);
#endif
            }
#ifndef SKIP_SC
            shortconv_phase(Pb, P.in[3], Hb, gt, gs);
#endif
        } else {
            for (int pi = bx; pi < 256; pi += G) { const int bh = pi >> 2, s = pi & 3; const float bfh = P.in[11][bh & 7];
#ifndef SKIP_ATT1
                attn_item<1>(lds, Pb, NIN1, 2048, 3072, 4096, Hb, 1024, bh >> 3, bh & 7, 7 - s, flog, bfh);
                attn_item<1>(lds, Pb, NIN1, 2048, 3072, 4096, Hb, 1024, bh >> 3, bh & 7, s, flog, bfh);
#endif
            }
#ifndef SKIP_GMLP
            for (int pr = bx; pr < 256; pr += G) { const int bn = pr >> 1, gh = pr & 1;
                gmlp_stats(lds, Pb, bn >> 4, bn & 15);
                for (int g4 = 0; g4 < 4; ++g4) gmlp_item(lds, Pb, P.in[12], P.in[13], P.in[14], Hb, bn >> 4, bn & 15, 4 * gh + g4); }
#endif
        }
        GSYNC();
        {
            pg8::Gemm g{Hb, Wt_out(layer), M, DM, DM}; pg8::StaticOrder S; S.init(M, DM, G, bx);
            if (layer == 0) { pg8::EpiResidT<true, false> E{P.in[0], X, DM, Hb2, ssq, nullptr};
                pg8::gemm_phase<pg8::EpiResidT<true, false>, pg8::StaticOrder, true, true>(lds, g, S, E); }
            else { pg8::EpiResidT<true, false, true> E{nullptr, X, DM, Hb2, ssq, Hb2};
                pg8::gemm_phase<pg8::EpiResidT<true, false, true>, pg8::StaticOrder, true, true>(lds, g, S, E); }
        }
        GSYNC();
#ifdef PROBE_UP
        for (int rep = 0; rep < 2; ++rep)
#endif
        {
            pg8::Gemm g{Hb2, Wt_up(layer), M, NUP, DM}; pg8::StaticOrder S; S.init(M, NUP, G, bx);
            LAS float* rsl = (LAS float*)(lds + MISC_OFF + 64);
            pg8::Unit u0; int pm0 = -1;
            if (S.next(0, u0)) { pm0 = u0.pm;
                PH_IDX
                if (tid < 256) { const float* sp = ssq + (size_t)(pm0 * 256 + tid) * 32; float t = 0.f;
#pragma unroll
                    for (int j = 0; j < 8; ++j) { const f32x4 a = *(const f32x4*)(sp + 4 * j); t += (a[0] + a[1]) + (a[2] + a[3]); }
                    rsl[tid] = 1.0f / sqrtf(t * (1.0f / 2048.0f) + 1e-6f); }
                __syncthreads(); }
            pg8::EpiUpConv E{Pb, (layer == 0 ? P.in[7] : P.in[18]), side, hal, ssq, rsl, (LAS float*)(lds + MISC_OFF + 1152), pm0};
#ifndef SKIP_UP
            pg8::gemm_phase<pg8::EpiUpConv, pg8::StaticOrder, true, true>(lds, g, S, E);
#endif
        }
        GSYNC();
        {
            pg8::Gemm g{Pb, Wt_dn(layer), M, DM, DFF}; pg8::StaticOrder S; S.init(M, DM, G, bx);
            {
                PH_IDX pg8::Unit fu;
                for (int i = 0; S.next(i, fu); ++i) fixup_tile(side, (layer == 0 ? P.in[7] : P.in[18]), Pb, fu.pm, tid);
                asm volatile("s_waitcnt vmcnt(0)" ::: "memory"); __syncthreads();
            }
            pg8::EpiResidT<true, false, true> E{nullptr, X, DM, Hb2, ssq, Hb2};
            pg8::gemm_phase<pg8::EpiResidT<true, false, true>, pg8::StaticOrder, true, true>(lds, g, S, E);
        }
        GSYNC();
        if (layer == 0) {
            PH_IDX
            LAS float* WfT = (LAS float*)lds;
            for (int idx = tid; idx < DM * 8; idx += 512) { const int k = idx >> 3, j = idx & 7; WfT[j * DM + k] = P.in[10][(size_t)k * LDW1 + NIN1 + j]; }
            __syncthreads();
#ifndef SKIP_RMS1
            rms1_rows_bf16(Hb2, ssq, P.in[9], Hb, WfT, flog, gw, ngw, lane);
#endif
            __syncthreads();
            GSYNC();
        }
    }
    {
        PH_IDX
        const float* gf = P.in[20];
        f32x4 gv[8];
#pragma unroll
        for (int j = 0; j < 8; ++j) gv[j] = ((const f32x4*)gf)[64 * j + lane];
        for (int m = gw; m < M; m += ngw) {
            const float part = (lane < 32) ? ssq[(size_t)m * 32 + lane] : 0.f;
            const float rs = 1.0f / sqrtf(wave_sum(part) * (1.0f / DM) + EPS);
            const u32x2* xr = (const u32x2*)(Hb2 + (size_t)m * DM) + lane;
            f32x4* o = (f32x4*)(X + (size_t)m * DM) + lane;
            u32x2 xv[8];
#pragma unroll
            for (int j = 0; j < 8; ++j) xv[j] = xr[64 * j];
#pragma unroll
            for (int j = 0; j < 8; ++j) { f32x4 v; v.x = bflo(xv[j].x); v.y = bfhi(xv[j].x); v.z = bflo(xv[j].y); v.w = bfhi(xv[j].y); o[64 * j] = v * rs * gv[j]; }
        }
    }
}

extern "C" void kernel_launch(void* const* d_in, const int* in_sizes, int n_in, void* d_out, int out_size, void* d_ws, size_t ws_size, hipStream_t stream) {
    static int grid = 0;
    if (grid == 0) {
        int dev = 0, cus = 0, per_cu = 0;
        (void)hipGetDevice(&dev);
        (void)hipDeviceGetAttribute(&cus, hipDeviceAttributeMultiprocessorCount, dev);
        (void)hipFuncSetAttribute((const void*)fwd, hipFuncAttributeMaxDynamicSharedMemorySize, LDS_BYTES);
        (void)hipOccupancyMaxActiveBlocksPerMultiprocessor(&per_cu, (const void*)fwd, 512, LDS_BYTES);
        (void)hipGetLastError();
        if (cus <= 0) cus = 256;
        grid = cus;
        if (n_in != 21 || ws_size < WS_END) fprintf(stderr, "kernel_launch: unexpected n_in %d / ws %zu\n", n_in, ws_size);
    }
    Params p{};
    for (int i = 0; i < 21 && i < n_in; ++i) p.in[i] = (const float*)d_in[i];
    p.out = (float*)d_out; p.ws = (unsigned char*)d_ws;
    void* args[] = {&p};
    hipError_t e = hipLaunchCooperativeKernel((const void*)fwd, dim3(grid), dim3(512), args, LDS_BYTES, stream);
    if (e != hipSuccess) fprintf(stderr, "cooperative launch failed: %s (grid %d)\n", hipGetErrorString(e), grid);
}
```
